# Optimizing an MI355X kernel written in HIP

```python
import jax, jax.numpy as jnp
from jax import lax
import numpy as np

D_MODEL = 1024
BATCH = 4
SEQ = 8192
DEPTH = 2

CTX_LEN = 256
GRID_W = 64
EPS = 1e-6
ADA_CHUNKS = 9
D_FF = 2816
FFN_RESIDUAL_WEIGHT = 0.5
D_MIX = D_MODEL
MLA_HEADS = 8
NOPE_DIM = 64
ROPE_DIM = 32
AXIS_DIM = ROPE_DIM // 2
QK_HEAD_DIM = NOPE_DIM + ROPE_DIM
V_HEAD_DIM = 64
Q_LORA = 384
KV_LORA = 256
ATT_WIDTH = MLA_HEADS * V_HEAD_DIM
ROPE_BASE = 10000.0
Q_BLOCK = 128
SG_GROUPS = 4
SG_GROUP_DIM = 64
SG_WIDTH = SG_GROUPS * SG_GROUP_DIM
CHUNK = 128
CONV_WIDTH = 256
CONV_K = 3
OFF_KV = Q_LORA
OFF_KPE = OFF_KV + KV_LORA
OFF_SG = OFF_KPE + ROPE_DIM
OFF_CONV = OFF_SG + 2 * SG_WIDTH
MIX_IN_DIM = OFF_CONV + 3 * CONV_WIDTH

kernel_name = 'hybrid_mla_sgu_shortconv_macaron_dit'


def rms_norm(x, g):
    xf = x.astype(jnp.float32)
    y = xf * lax.rsqrt(jnp.mean(xf * xf, axis=-1, keepdims=True) + EPS)
    return (y * g.astype(jnp.float32)).astype(x.dtype)


def modulate(h, shift, scale):
    return h * (1 + scale) + shift


def ffn_half_step(h, shift, scale, gate, g, w_in, w_out):
    a, b = jnp.split(modulate(rms_norm(h, g), shift, scale) @ w_in, 2, axis=-1)
    return h + FFN_RESIDUAL_WEIGHT * gate * ((jax.nn.silu(a) * b) @ w_out)


def axial_rope_tables(n, dtype):
    rows = n // GRID_W
    row = jnp.repeat(jnp.arange(rows), GRID_W).astype(jnp.float32)
    col = jnp.tile(jnp.arange(GRID_W), rows).astype(jnp.float32)
    inv = 1.0 / (ROPE_BASE ** (jnp.arange(0, AXIS_DIM, 2, dtype=jnp.float32) / AXIS_DIM))
    ang_r = row[:, None] * inv
    ang_c = col[:, None] * inv
    ang = jnp.concatenate([ang_r, ang_r, ang_c, ang_c], axis=-1)
    return jnp.cos(ang).astype(dtype), jnp.sin(ang).astype(dtype)


def rotate_half(t):
    a, b = jnp.split(t, 2, axis=-1)
    return jnp.concatenate([-b, a], axis=-1)


def apply_rope(x, rope):
    cos, sin = rope
    x_nope, x_pe = x[..., :NOPE_DIM], x[..., NOPE_DIM:]
    xr, xc = jnp.split(x_pe, 2, axis=-1)
    rot = jnp.concatenate([rotate_half(xr), rotate_half(xc)], axis=-1)
    x_pe = x_pe * cos[None, :, None, :] + rot * sin[None, :, None, :]
    return jnp.concatenate([x_nope, x_pe], axis=-1)


def mla_queries(q_lat, g_q_lat, w_q_up, g_q_head, rope):
    b, n, _ = q_lat.shape
    q = (rms_norm(q_lat, g_q_lat) @ w_q_up).reshape(b, n, MLA_HEADS, QK_HEAD_DIM)
    q = rms_norm(q, g_q_head)
    return apply_rope(q, rope) if rope is not None else q


def mla_keys_values(kv_lat, k_pe, g_kv_lat, w_kv_up, g_k_head, rope):
    b, n, _ = kv_lat.shape
    kv = (rms_norm(kv_lat, g_kv_lat) @ w_kv_up).reshape(b, n, MLA_HEADS, NOPE_DIM + V_HEAD_DIM)
    k_nope, v = kv[..., :NOPE_DIM], kv[..., NOPE_DIM:]
    k_pe = jnp.broadcast_to(k_pe[:, :, None, :], (b, n, MLA_HEADS, ROPE_DIM))
    k = rms_norm(jnp.concatenate([k_nope, k_pe], axis=-1), g_k_head)
    k = apply_rope(k, rope) if rope is not None else k
    return k, v


def softmax_attend(q, k, v):
    s = jnp.einsum('bqhd,bkhd->bhqk', q, k, preferred_element_type=jnp.float32) * (QK_HEAD_DIM ** -0.5)
    p = jax.nn.softmax(s, axis=-1).astype(v.dtype)
    return jnp.einsum('bhqk,bkhd->bqhd', p, v)


def latent_attention(q, k_lat, v_lat, k_ctx, v_ctx):
    b, n, h, dq = q.shape
    k_all = jnp.concatenate([k_lat, k_ctx], axis=1)
    v_all = jnp.concatenate([v_lat, v_ctx], axis=1)
    qb = q.reshape(b, n // Q_BLOCK, Q_BLOCK, h, dq).transpose(1, 0, 2, 3, 4)
    o = lax.map(lambda qblk: softmax_attend(qblk, k_all, v_all), qb)
    return o.transpose(1, 0, 2, 3, 4).reshape(b, n, h * V_HEAD_DIM)


def spatial_gating(sg_in, g_sgu, w_spatial, b_spatial):
    b, n, _ = sg_in.shape
    u, v = jnp.split(jax.nn.gelu(sg_in), 2, axis=-1)
    v = rms_norm(v.reshape(b, n, SG_GROUPS, SG_GROUP_DIM), g_sgu)
    v = v.reshape(b, n // CHUNK, CHUNK, SG_GROUPS, SG_GROUP_DIM)
    vs = jnp.einsum('gpq,bnqgc->bnpgc', w_spatial, v) + b_spatial.T[:, :, None]
    return u * vs.reshape(b, n, SG_WIDTH)


def short_conv(cv_in, w_conv):
    b_gate, c_gate, xin = jnp.split(cv_in, 3, axis=-1)
    z = c_gate * xin
    y = lax.conv_general_dilated(z, w_conv[:, None, :], window_strides=(1,), padding=[(1, 1)],
                                 dimension_numbers=('NWC', 'WIO', 'NWC'), feature_group_count=CONV_WIDTH)
    return b_gate * y


def merge_groups(attn, sg, cv, g_out, w_mix_out):
    y = jnp.concatenate([rms_norm(attn, g_out[:ATT_WIDTH]),
                         rms_norm(sg, g_out[ATT_WIDTH:ATT_WIDTH + SG_WIDTH]),
                         rms_norm(cv, g_out[ATT_WIDTH + SG_WIDTH:])], axis=-1)
    return y @ w_mix_out


def setup_inputs(seed: int = 0) -> dict:
    key = jax.random.key(seed)
    ks = iter(jax.random.split(key, 40))

    def nrm(shape, scale):
        return jax.random.normal(next(ks), shape, jnp.float32) * scale

    def gain(shape):
        return 1.0 + nrm(shape, 0.02)

    L, D = DEPTH, D_MODEL
    return {
        'x': nrm((BATCH, SEQ, D), 1.0),
        'c': nrm((BATCH, D), 1.0),
        'ctx': nrm((BATCH, CTX_LEN, D), 1.0),
        'c_ctx': nrm((D,), 1.0),
        'w_ada': nrm((L, D, ADA_CHUNKS * D), 0.5 * D ** -0.5),
        'b_ada': nrm((L, ADA_CHUNKS * D), 0.02),
        'g_ffn1': gain((L, D)),
        'w_ffn1_in': nrm((L, D, 2 * D_FF), D ** -0.5),
        'w_ffn1_out': nrm((L, D_FF, D), D_FF ** -0.5),
        'g_mix': gain((L, D)),
        'w_mix_in': nrm((L, D, MIX_IN_DIM), D ** -0.5),
        'g_q_lat': gain((L, Q_LORA)),
        'w_q_up': nrm((L, Q_LORA, MLA_HEADS * QK_HEAD_DIM), Q_LORA ** -0.5),
        'g_kv_lat': gain((L, KV_LORA)),
        'w_kv_up': nrm((L, KV_LORA, MLA_HEADS * (NOPE_DIM + V_HEAD_DIM)), KV_LORA ** -0.5),
        'g_q_head': gain((L, QK_HEAD_DIM)),
        'g_k_head': gain((L, QK_HEAD_DIM)),
        'g_sgu': gain((L, SG_GROUPS, SG_GROUP_DIM)),
        'w_spatial': nrm((L, SG_GROUPS, CHUNK, CHUNK), CHUNK ** -0.5),
        'b_spatial': 1.0 + nrm((L, SG_GROUPS, CHUNK), 0.02),
        'w_conv': nrm((L, CONV_K, CONV_WIDTH), CONV_K ** -0.5),
        'g_out': gain((L, D_MIX)),
        'w_mix_out': nrm((L, D_MIX, D), D_MIX ** -0.5),
        'g_ffn2': gain((L, D)),
        'w_ffn2_in': nrm((L, D, 2 * D_FF), D ** -0.5),
        'w_ffn2_out': nrm((L, D_FF, D), D_FF ** -0.5),
    }


def reference(x, c, ctx, c_ctx, w_ada, b_ada, g_ffn1, w_ffn1_in, w_ffn1_out, g_mix, w_mix_in,
              g_q_lat, w_q_up, g_kv_lat, w_kv_up, g_q_head, g_k_head, g_sgu, w_spatial, b_spatial,
              w_conv, g_out, w_mix_out, g_ffn2, w_ffn2_in, w_ffn2_out):
    rope = axial_rope_tables(x.shape[1], x.dtype)
    h, hc = x, ctx
    sc, scc = jax.nn.silu(c), jax.nn.silu(c_ctx)
    splits = [OFF_KV, OFF_KPE, OFF_SG, OFF_CONV]
    for l in range(DEPTH):
        last = l == DEPTH - 1
        mod_l = jnp.split((sc @ w_ada[l] + b_ada[l])[:, None, :], ADA_CHUNKS, axis=-1)
        mod_c = jnp.split((scc @ w_ada[l] + b_ada[l])[None, None, :], ADA_CHUNKS, axis=-1)

        h = ffn_half_step(h, mod_l[0], mod_l[1], mod_l[2], g_ffn1[l], w_ffn1_in[l], w_ffn1_out[l])
        hc = ffn_half_step(hc, mod_c[0], mod_c[1], mod_c[2], g_ffn1[l], w_ffn1_in[l], w_ffn1_out[l])

        hn = modulate(rms_norm(h, g_mix[l]), mod_l[3], mod_l[4])
        hnc = modulate(rms_norm(hc, g_mix[l]), mod_c[3], mod_c[4])
        q_lat, kv_lat, k_pe, sg_in, cv_in = jnp.split(hn @ w_mix_in[l], splits, axis=-1)
        if last:
            kv_lat_c, k_pe_c = jnp.split(hnc @ w_mix_in[l][:, OFF_KV:OFF_SG], [KV_LORA], axis=-1)
        else:
            q_lat_c, kv_lat_c, k_pe_c, sg_in_c, cv_in_c = jnp.split(hnc @ w_mix_in[l], splits, axis=-1)
        q = mla_queries(q_lat, g_q_lat[l], w_q_up[l], g_q_head[l], rope)
        k, v = mla_keys_values(kv_lat, k_pe, g_kv_lat[l], w_kv_up[l], g_k_head[l], rope)
        kc, vc = mla_keys_values(kv_lat_c, k_pe_c, g_kv_lat[l], w_kv_up[l], g_k_head[l], None)
        attn = latent_attention(q, k, v, kc, vc)
        sg = spatial_gating(sg_in, g_sgu[l], w_spatial[l], b_spatial[l])
        cv = short_conv(cv_in, w_conv[l])
        h = h + mod_l[5] * merge_groups(attn, sg, cv, g_out[l], w_mix_out[l])

        h = ffn_half_step(h, mod_l[6], mod_l[7], mod_l[8], g_ffn2[l], w_ffn2_in[l], w_ffn2_out[l])

        if not last:
            qc = mla_queries(q_lat_c, g_q_lat[l], w_q_up[l], g_q_head[l], None)
            b_sz = hc.shape[0]
            attn_c = softmax_attend(qc, kc, vc).reshape(b_sz, hc.shape[1], ATT_WIDTH)
            sg_c = spatial_gating(sg_in_c, g_sgu[l], w_spatial[l], b_spatial[l])
            cv_c = short_conv(cv_in_c, w_conv[l])
            hc = hc + mod_c[5] * merge_groups(attn_c, sg_c, cv_c, g_out[l], w_mix_out[l])
            hc = ffn_half_step(hc, mod_c[6], mod_c[7], mod_c[8], g_ffn2[l], w_ffn2_in[l], w_ffn2_out[l])
    return h
```

```cpp
#include <hip/hip_runtime.h>
#include <hip/hip_cooperative_groups.h>
#include <cstdio>
#include <cstdint>
namespace cg = cooperative_groups;

#ifndef MK_MULTI
#define MK_MULTI 0
#endif

#ifndef PHMASK
#define PHMASK 0xFFFF
#endif
#define PHEN(n) (((PHMASK) >> (n)) & 1)
#ifndef REPK
#define REPK -1
#endif
#define LAS __attribute__((address_space(3)))
typedef unsigned short bf16;
typedef short bf16x8 __attribute__((ext_vector_type(8)));
typedef short s16x4 __attribute__((ext_vector_type(4)));
typedef float f32x4 __attribute__((ext_vector_type(4)));
typedef float f32x2 __attribute__((ext_vector_type(2)));
typedef float f32x16 __attribute__((ext_vector_type(16)));
typedef unsigned u32x4 __attribute__((ext_vector_type(4)));
typedef unsigned u32x2 __attribute__((ext_vector_type(2)));
typedef __bf16 bf16x2_t __attribute__((ext_vector_type(2)));

constexpr int DM = 1024, NB = 4, SEQ = 8192, NCTX = 256, DFF = 2816;
constexpr int MLAT = NB * SEQ, MCTX = NB * NCTX, MTOT = MLAT + MCTX;
constexpr int NH = 8, DQK = 96, DV = 64, QLORA = 384, KVLORA = 256;
constexpr int OFF_KV = 384, OFF_KPE = 640, OFF_SG = 672, OFF_CONV = 1184, MIXN = 1952, MIXP = 2048;
constexpr int ADA = 9 * DM;
constexpr float EPS = 1e-6f;

constexpr size_t MiB = 1u << 20;
constexpr size_t WS_MOD = 0, WS_ROPE = 1 * MiB, WS_CTL = 1 * MiB + 512 * 1024, CTL_BYTES = 16384, WS_W = 2 * MiB, W_LAYER = 41 * MiB;
constexpr size_t WO_FFN1IN = 0, WO_FFN1OUT = 11 * MiB, WO_MIXIN = WO_FFN1OUT + 5767168, WO_QUP = WO_MIXIN + 4 * MiB, WO_KVUP = WO_QUP + 589824,
                 WO_MIXOUT = WO_KVUP + 524288, WO_FFN2IN = WO_MIXOUT + 2 * MiB, WO_FFN2OUT = WO_FFN2IN + 11 * MiB;
static_assert(WO_FFN2OUT + 5767168 <= W_LAYER, "weights");
constexpr size_t WS_HC = 84 * MiB, WS_A = 88 * MiB, WS_R = 154 * MiB;
constexpr size_t R_U = 0, R_MIX = 0, R_O = 0  , R_V = 132 * MiB  , R_QRAW = 165 * MiB, R_KVRAW = R_QRAW + (size_t)MTOT * 768 * 2, R_K = R_KVRAW + 66 * MiB;
constexpr size_t WS_END = WS_R + R_K + (size_t)MTOT * 768 * 2;
static_assert(WS_END <= 512 * MiB, "ws");
static_assert((size_t)MTOT * DFF * 2 <= 330 * MiB, "U");

__device__ __forceinline__ unsigned pk2(float lo, float hi) { f32x2 v = {lo, hi}; bf16x2_t b = __builtin_convertvector(v, bf16x2_t); return __builtin_bit_cast(unsigned, b); }
__device__ __forceinline__ float bflo(unsigned w) { return __uint_as_float(w << 16); }
__device__ __forceinline__ float bfhi(unsigned w) { return __uint_as_float(w & 0xffff0000u); }
__device__ __forceinline__ float bf1(bf16 h) { return __uint_as_float((unsigned)h << 16); }
__device__ __forceinline__ float wave_sum(float v) {
#pragma unroll
    for (int o = 1; o < 64; o <<= 1) v += __shfl_xor(v, o);
    return v;
}
__device__ __forceinline__ float fsilu(float x) { return x * __builtin_amdgcn_rcpf(1.f + __builtin_amdgcn_exp2f(-1.4426950408889634f * x)); }
__device__ __forceinline__ float fgelu(float x) {
    const float z = 1.5957691216057308f * (x + 0.044715f * x * x * x);
    return x * __builtin_amdgcn_rcpf(1.f + __builtin_amdgcn_exp2f(-1.4426950408889634f * z));
}

namespace pg8 {
constexpr int BM = 256, BK = 64, HALF = 128, HTB = HALF * BK * 2, STAGE_BYTES = 8 * HTB, NXCD = 8, WGM = 8;
__host__ __device__ __forceinline__ int lds_byte(int r, int c) { const int st = (r >> 4) * 2 + (c >> 5), rr = r & 15, cc = c & 31, ob = rr * 64 + cc * 2; return st * 1024 + (ob ^ (((ob >> 9) & 1) << 5)); }
__host__ __device__ __forceinline__ void stage_rc(int b, int& R, int& C) { const int st = b / 1024, sb = b % 1024, swz = sb ^ (((sb >> 9) & 1) << 5); R = (st >> 1) * 16 + swz / 64; C = (st & 1) * 32 + (swz % 64) / 2; }
__host__ __device__ __forceinline__ int perm32(int rho) { const int n = rho >> 4, i = rho & 15; return 8 * (i >> 2) + 4 * n + (i & 3); }
struct Unit { int pm, pn, k0, nt; };
struct Gemm { const bf16* A; const bf16* Bt; int M, N, K, lda; };
struct StaticOrder {
    int nM, nN, nwg, G, c, ntfull, nsplit, ntsub, ntail;
    __device__ void init(int M, int N, int K, int G_, int c_, int Msplit = 0, int ntsub_ = 0) {
        nM = (M - Msplit) / BM; nN = N / BM; nwg = nM * nN; G = G_; c = c_; ntfull = K / BK;
        ntsub = ntsub_ > 0 ? ntsub_ : ntfull; nsplit = ntfull / ntsub; ntail = (Msplit / BM) * nN * nsplit; }
    __device__ bool next(int i, Unit& u) const {
        const long L = (long)i * G + c; if (L >= nwg + ntail) return false;
        if (L >= nwg) { const int s = (int)L - nwg, nt4 = (ntail / nsplit), tile = s % nt4, ks = s / nt4; u.pm = nM + tile / nN; u.pn = tile % nN; u.k0 = ks * ntsub; u.nt = ntsub; return true; }
        int wgid = (int)L; { const int q = nwg / NXCD, r = nwg % NXCD, xcd = wgid % NXCD, off = wgid / NXCD; wgid = (xcd < r ? xcd * (q + 1) : r * (q + 1) + (xcd - r) * q) + off; }
        const int nig = WGM * nN, gid = wgid / nig, fm = gid * WGM, gsz = (nM - fm) < WGM ? (nM - fm) : WGM;
        u.pm = fm + ((wgid % nig) % gsz); u.pn = (wgid % nig) / gsz; u.k0 = 0; u.nt = ntfull; return true;
    }
};
struct EpiStore {
    static constexpr bool PERM = true;
    bf16* O; int ldc;
    __device__ __forceinline__ void operator()(const f32x4 (&acc)[2][2][4][2], const Unit& u, int wr, int wc, int fr, int fq) const {
        const int row0 = u.pm * BM + wr * 64 + fr, col0 = u.pn * BM + wc * 32 + 8 * fq;
#pragma unroll
        for (int ai = 0; ai < 2; ++ai)
#pragma unroll
            for (int m = 0; m < 4; ++m) { bf16* rowp = O + (size_t)(row0 + ai * HALF + m * 16) * ldc + col0;
#pragma unroll
                for (int bj = 0; bj < 2; ++bj) { const f32x4 v0 = acc[ai][bj][m][0], v1 = acc[ai][bj][m][1];
                    u32x4 w; w.x = pk2(v0[0], v0[1]); w.y = pk2(v0[2], v0[3]); w.z = pk2(v1[0], v1[1]); w.w = pk2(v1[2], v1[3]);
                    *(u32x4*)(rowp + bj * HALF) = w; } }
    }
};
struct EpiSwiGLU {
    static constexpr bool PERM = true;
    bf16* U; int ldu;
    __device__ __forceinline__ void operator()(const f32x4 (&acc)[2][2][4][2], const Unit& u, int wr, int wc, int fr, int fq) const {
        const int row0 = u.pm * BM + wr * 64 + fr, col0 = u.pn * HALF + wc * 32 + 8 * fq;
#pragma unroll
        for (int ai = 0; ai < 2; ++ai)
#pragma unroll
            for (int m = 0; m < 4; ++m) { bf16* rowp = U + (size_t)(row0 + ai * HALF + m * 16) * ldu + col0;
                const f32x4 a0 = acc[ai][0][m][0], a1 = acc[ai][0][m][1], b0 = acc[ai][1][m][0], b1 = acc[ai][1][m][1];
                u32x4 w; w.x = pk2(fsilu(a0[0]) * b0[0], fsilu(a0[1]) * b0[1]); w.y = pk2(fsilu(a0[2]) * b0[2], fsilu(a0[3]) * b0[3]);
                w.z = pk2(fsilu(a1[0]) * b1[0], fsilu(a1[1]) * b1[1]); w.w = pk2(fsilu(a1[2]) * b1[2], fsilu(a1[3]) * b1[3]);
                *(u32x4*)rowp = w; }
    }
};
struct EpiResid {
    static constexpr bool PERM = true;
    const float* rin_lat; const float* rin_ctx; float* out_lat; float* out_ctx; const float* gate; float coef; int ntfull; float* part;
    __device__ __forceinline__ void operator()(const f32x4 (&acc)[2][2][4][2], const Unit& u, int wr, int wc, int fr, int fq) const {
        asm volatile("" : "+v"(fr), "+v"(fq));
        const bool lat = u.pm < MLAT / BM; const int s = lat ? (u.pm >> 5) : 4;
        const size_t tbase = lat ? (size_t)u.pm * BM * DM : (size_t)(u.pm - MLAT / BM) * BM * DM;
        const long long di = lat ? 0ll : (long long)((const char*)rin_ctx - (const char*)rin_lat), dq = lat ? 0ll : (long long)((char*)out_ctx - (char*)out_lat);
        const float* rin = (const float*)((const char*)rin_lat + di) + tbase; float* out = (float*)((char*)out_lat + dq) + tbase;
        const int col0 = u.pn * BM + wc * 32 + 8 * fq;
        if (u.nt != ntfull) {
            float* pp = part + (size_t)(u.k0 / u.nt) * ((size_t)MCTX * DM) + tbase;
#pragma unroll
            for (int bj = 0; bj < 2; ++bj) { const int col = col0 + bj * HALF; const f32x4 g0 = *(const f32x4*)(gate + (size_t)s * ADA + col) * coef, g1 = *(const f32x4*)(gate + (size_t)s * ADA + col + 4) * coef;
#pragma unroll
                for (int ai = 0; ai < 2; ++ai)
#pragma unroll
                    for (int m = 0; m < 4; ++m) { const size_t off = (size_t)(ai * HALF + wr * 64 + m * 16 + fr) * DM + col; *(f32x4*)(pp + off) = g0 * acc[ai][bj][m][0]; *(f32x4*)(pp + off + 4) = g1 * acc[ai][bj][m][1]; } }
            return;
        }
#pragma unroll
        for (int bj = 0; bj < 2; ++bj) { const int col = col0 + bj * HALF; const f32x4 g0 = *(const f32x4*)(gate + (size_t)s * ADA + col) * coef, g1 = *(const f32x4*)(gate + (size_t)s * ADA + col + 4) * coef;
#pragma unroll
            for (int ai = 0; ai < 2; ++ai) { f32x4 r[4][2];
#pragma unroll
                for (int m = 0; m < 4; ++m) { const size_t off = (size_t)(ai * HALF + wr * 64 + m * 16 + fr) * DM + col; r[m][0] = *(const f32x4*)(rin + off); r[m][1] = *(const f32x4*)(rin + off + 4); }
                asm volatile("" ::: "memory");
#pragma unroll
                for (int m = 0; m < 4; ++m) { const size_t off = (size_t)(ai * HALF + wr * 64 + m * 16 + fr) * DM + col;
                    *(f32x4*)(out + off) = r[m][0] + g0 * acc[ai][bj][m][0]; *(f32x4*)(out + off + 4) = r[m][1] + g1 * acc[ai][bj][m][1]; }
                asm volatile("" ::: "memory"); } }
    }
};

template <class Epi>
__device__ __forceinline__ void gemm_phase(LAS unsigned char* lds, const Gemm g, const StaticOrder& S, const Epi& E, const int tid) {
    const int wid = __builtin_amdgcn_readfirstlane(tid >> 6), lane = tid & 63, wr = wid >> 2, wc = wid & 3, fr = lane & 15, fq = lane >> 4;
    const int K = g.K, lda = g.lda;
    unsigned voffA[2], voffB[2];
#pragma unroll
    for (int i = 0; i < 2; ++i) { int R, C; stage_rc(tid * 16 + i * 8192, R, C); const int Rb = Epi::PERM ? ((R & ~31) + perm32(R & 31)) : R;
        voffA[i] = (unsigned)(R * lda + C) * 2u; voffB[i] = (unsigned)(Rb * K + C) * 2u; }
    const size_t kstep = (size_t)(BK * 2);
    const size_t hstepA = (size_t)HALF * lda * 2, hstepB = (size_t)HALF * K * 2;
    const size_t tstepA = 2 * hstepA, tstepB = 2 * hstepB;
    const unsigned ldsw = (unsigned)wid * 1024u;
    const int aoff = lds_byte(wr * 64 + fr, fq * 8), boff = lds_byte(wc * 32 + fr, fq * 8);
#define PG8_SA(b, h) (((b) * 2 + (h)) * HTB)
#define PG8_SB(b, h) ((4 + (b) * 2 + (h)) * HTB)
#define PG8_STAGE(bufoff, gbase, voff) do { _Pragma("unroll") for (int _i = 0; _i < 2; ++_i) \
        __builtin_amdgcn_global_load_lds((const unsigned*)((const char*)(gbase) + (voff)[_i]), (LAS unsigned*)(lds + (bufoff) + ldsw + _i * 8192), 16, 0, 0); } while (0)
#define PG8_LDA(dst, b, h) do { _Pragma("unroll") for (int m = 0; m < 4; ++m) _Pragma("unroll") for (int k = 0; k < 2; ++k) dst[m][k] = *(const LAS bf16x8*)(lds + PG8_SA(b, h) + aoff + m * 2048 + k * 1024); } while (0)
#define PG8_LDB(dst, b, h) do { _Pragma("unroll") for (int n = 0; n < 2; ++n) _Pragma("unroll") for (int k = 0; k < 2; ++k) dst[n][k] = *(const LAS bf16x8*)(lds + PG8_SB(b, h) + boff + n * 2048 + k * 1024); } while (0)
#define PG8_MMA(ai, bj, At, Bt) do { __builtin_amdgcn_s_setprio(1); _Pragma("unroll") for (int m = 0; m < 4; ++m) _Pragma("unroll") for (int n = 0; n < 2; ++n) _Pragma("unroll") for (int k = 0; k < 2; ++k) \
        acc[ai][bj][m][n] = __builtin_amdgcn_mfma_f32_16x16x32_bf16(Bt[n][k], At[m][k], acc[ai][bj][m][n], 0, 0, 0); __builtin_amdgcn_s_setprio(0); } while (0)
#define PG8_WAIT_V(n) asm volatile("s_waitcnt vmcnt(" #n ")" ::: "memory")
#define PG8_WAIT_L(n) asm volatile("s_waitcnt lgkmcnt(" #n ")" ::: "memory")
#define PG8_BAR __builtin_amdgcn_s_barrier()
#define PG8_SCHED __builtin_amdgcn_sched_barrier(0)
    Unit cur, nxt; int ui = 0;
    if (!S.next(0, cur)) return;
    f32x4 acc[2][2][4][2];
#pragma unroll
    for (int a = 0; a < 2; ++a)
#pragma unroll
        for (int b = 0; b < 2; ++b)
#pragma unroll
            for (int m = 0; m < 4; ++m)
#pragma unroll
                for (int n = 0; n < 2; ++n) acc[a][b][m][n] = (f32x4){0.f, 0.f, 0.f, 0.f};
    bf16x8 At[4][2], B0[2][2], B1[2][2];
    const char* cA = (const char*)g.A + (size_t)cur.pm * tstepA + (size_t)cur.k0 * kstep; const char* cB = (const char*)g.Bt + (size_t)cur.pn * tstepB + (size_t)cur.k0 * kstep;
    PG8_STAGE(PG8_SB(0, 0), cB, voffB); PG8_STAGE(PG8_SB(0, 1), cB + hstepB, voffB); PG8_STAGE(PG8_SA(0, 0), cA, voffA); PG8_STAGE(PG8_SA(0, 1), cA + hstepA, voffA);
    if (wr == 1) PG8_BAR;
    PG8_WAIT_V(2); PG8_BAR;
    PG8_STAGE(PG8_SB(1, 0), cB + kstep, voffB); PG8_STAGE(PG8_SA(1, 0), cA + kstep, voffA); PG8_STAGE(PG8_SB(1, 1), cB + hstepB + kstep, voffB);
    PG8_WAIT_V(6); PG8_BAR;
    for (;;) {
        const bool has_next = S.next(ui + 1, nxt);
        const char* nA = has_next ? (const char*)g.A + (size_t)nxt.pm * tstepA + (size_t)nxt.k0 * kstep : cA; const char* nB = has_next ? (const char*)g.Bt + (size_t)nxt.pn * tstepB + (size_t)nxt.k0 * kstep : cB;
        const int nt = cur.nt;
        for (int t = 0; t < nt; t += 2) {
            const bool last = (t == nt - 2);
            const char* a1 = cA + (size_t)(t + 1) * kstep;
            const char* a2 = last ? nA : cA + (size_t)(t + 2) * kstep; const char* b2 = last ? nB : cB + (size_t)(t + 2) * kstep;
            const char* a3 = a2 + kstep; const char* b3 = b2 + kstep;
            PG8_LDB(B0, 0, 0); PG8_LDB(B1, 0, 1); PG8_SCHED; PG8_LDA(At, 0, 0); PG8_STAGE(PG8_SA(1, 1), a1 + hstepA, voffA);
            PG8_WAIT_V(8); PG8_WAIT_L(0); PG8_BAR; PG8_MMA(0, 0, At, B0); PG8_MMA(0, 1, At, B1); PG8_BAR; PG8_SCHED;
            PG8_LDA(At, 0, 1); PG8_STAGE(PG8_SB(0, 0), b2, voffB); PG8_STAGE(PG8_SB(0, 1), b2 + hstepB, voffB); PG8_STAGE(PG8_SA(0, 0), a2, voffA);
            PG8_WAIT_V(8); PG8_WAIT_L(0); PG8_BAR; PG8_MMA(1, 0, At, B0); PG8_MMA(1, 1, At, B1); PG8_BAR; PG8_SCHED;
            PG8_LDB(B0, 1, 0); PG8_LDB(B1, 1, 1); PG8_SCHED; PG8_LDA(At, 1, 0); PG8_STAGE(PG8_SA(0, 1), a2 + hstepA, voffA);
            PG8_WAIT_V(8); PG8_WAIT_L(0); PG8_BAR; PG8_MMA(0, 0, At, B0); PG8_MMA(0, 1, At, B1); PG8_BAR; PG8_SCHED;
            PG8_LDA(At, 1, 1); PG8_STAGE(PG8_SB(1, 0), b3, voffB); PG8_STAGE(PG8_SB(1, 1), b3 + hstepB, voffB); PG8_STAGE(PG8_SA(1, 0), a3, voffA);
            PG8_WAIT_V(8); PG8_WAIT_L(0); PG8_BAR; PG8_MMA(1, 0, At, B0); PG8_MMA(1, 1, At, B1); PG8_BAR; PG8_SCHED;
        }
        if (wr == 0) PG8_BAR;
        E(acc, cur, wr, wc, fr, fq);
        if (!has_next) break;
#pragma unroll
        for (int a = 0; a < 2; ++a)
#pragma unroll
            for (int b = 0; b < 2; ++b)
#pragma unroll
                for (int m = 0; m < 4; ++m)
#pragma unroll
                    for (int n = 0; n < 2; ++n) acc[a][b][m][n] = (f32x4){0.f, 0.f, 0.f, 0.f};
        cur = nxt; cA = nA; cB = nB; ++ui;
        if (wr == 1) PG8_BAR;
    }
    PG8_WAIT_V(0);
    PG8_BAR;
#undef PG8_SA
#undef PG8_SB
#undef PG8_STAGE
#undef PG8_LDA
#undef PG8_LDB
#undef PG8_MMA
#undef PG8_WAIT_V
#undef PG8_WAIT_L
#undef PG8_BAR
#undef PG8_SCHED
}
}

namespace att {
constexpr int NW = 8, QBLK = 32, KVBLK = 64;
constexpr float SCALE = 0.10206207261596575f;
constexpr float THR = 8.f;
constexpr int SHM_V = KVBLK * DV * 2, SHM_K = KVBLK * 256;
constexpr int LDS_V = 0, LDS_K = 2 * SHM_V, LDS_WS = LDS_K + 2 * SHM_K, LDS_BYTES = LDS_WS + NW * 64 * 4;
#define KSWZ(row, colB) ((row) * 256 + ((colB) ^ (((row) & 7) << 4)))
#define SBAR() __builtin_amdgcn_sched_barrier(0)
__device__ __forceinline__ int crow(int r, int hi) { return (r & 3) + 8 * (r >> 2) + 4 * hi; }
__device__ __forceinline__ unsigned cvtpk(float lo, float hi) { unsigned r; asm volatile("v_cvt_pk_bf16_f32 %0, %1, %2" : "=v"(r) : "v"(lo), "v"(hi)); return r; }
__device__ __forceinline__ void partialSM(f32x16& p0, f32x16& p1, float& m_reg, float& mn, float& alpha) {
    constexpr float C = 1.0f;
    float pmax = p0[0];
#pragma unroll
    for (int r = 1; r < 16; ++r) pmax = fmaxf(pmax, p0[r]);
#pragma unroll
    for (int r = 0; r < 16; ++r) pmax = fmaxf(pmax, p1[r]);
    { auto rr = __builtin_amdgcn_permlane32_swap(__float_as_uint(pmax), __float_as_uint(pmax), false, false);
      pmax = fmaxf(__uint_as_float(rr[0]), __uint_as_float(rr[1])); }
    if (__builtin_expect(__all(pmax - m_reg <= THR * 1.4426950408889634f), 1)) { mn = m_reg; alpha = 1.f; }
    else { mn = fmaxf(m_reg, pmax); alpha = __builtin_amdgcn_exp2f((m_reg - mn) * C); m_reg = mn; }
    const float mnC = -mn * C;
#pragma unroll
    for (int r = 0; r < 16; ++r) p0[r] = fmaf(p0[r], C, mnC);
#pragma unroll
    for (int r = 0; r < 16; ++r) p1[r] = fmaf(p1[r], C, mnC);
#pragma unroll
    for (int r = 0; r < 16; ++r) p0[r] = __builtin_amdgcn_exp2f(p0[r]);
}
__device__ __forceinline__ void finishSM(f32x16& p0, f32x16& p1, float alpha, float& l_reg, bf16x8& pa0, bf16x8& pa1, bf16x8& pa2, bf16x8& pa3) {
#pragma unroll
    for (int r = 0; r < 16; ++r) p1[r] = __builtin_amdgcn_exp2f(p1[r]);
    float ps = 0;
#pragma unroll
    for (int r = 0; r < 16; ++r) ps += p0[r];
#pragma unroll
    for (int r = 0; r < 16; ++r) ps += p1[r];
    { auto rr = __builtin_amdgcn_permlane32_swap(__float_as_uint(ps), __float_as_uint(ps), false, false);
      ps = __uint_as_float(rr[0]) + __uint_as_float(rr[1]); }
    l_reg = l_reg * alpha + ps;
#define PK4(P, BASE, OUT) do { unsigned a0 = cvtpk(P[BASE + 0], P[BASE + 1]), a1 = cvtpk(P[BASE + 2], P[BASE + 3]);   \
    unsigned b0 = cvtpk(P[BASE + 4], P[BASE + 5]), b1 = cvtpk(P[BASE + 6], P[BASE + 7]);                              \
    auto r0 = __builtin_amdgcn_permlane32_swap(a0, b0, false, false); auto r1 = __builtin_amdgcn_permlane32_swap(a1, b1, false, false); \
    u32x4 w = {r0[0], r1[0], r0[1], r1[1]}; OUT = __builtin_bit_cast(bf16x8, w); } while (0)
    PK4(p0, 0, pa0); PK4(p0, 8, pa1); PK4(p1, 0, pa2); PK4(p1, 8, pa3);
#undef PK4
}
__device__ __forceinline__ void qkt(f32x16& p0, f32x16& p1, const char* Ks, const bf16x8* qr, int r32, int hi) {
    p0 = f32x16{}; p1 = f32x16{};
#pragma unroll
    for (int d0 = 0; d0 < 6; ++d0) { const int cb = (d0 * 16 + hi * 8) * 2;
        const bf16x8 b0 = *reinterpret_cast<const bf16x8*>(Ks + KSWZ(r32, cb));
        const bf16x8 b1 = *reinterpret_cast<const bf16x8*>(Ks + KSWZ(32 + r32, cb));
        p0 = __builtin_amdgcn_mfma_f32_32x32x16_bf16(b0, qr[d0], p0, 0, 0, 0);
        p1 = __builtin_amdgcn_mfma_f32_32x32x16_bf16(b1, qr[d0], p1, 0, 0, 0); }
}
__device__ __forceinline__ int v_st(int k, int c) { const int kk = (k & ~0xC) | ((k & 4) << 1) | ((k & 8) >> 1); return ((kk >> 3) * 2 + (c >> 5)) * 512 + ((kk & 7) * 32 + (c & 31)) * 2; }
__device__ __forceinline__ int v_rd_base(int lane) { return ((lane & 3) << 3) | (((lane >> 2) & 3) << 6) | (((lane >> 4) & 1) << 5) | (((lane >> 5) & 1) << 8); }
constexpr int v_rd_off(int d0, int ks, int half) { return d0 * 512 + ks * 2048 + half * 1024; }
template <int OFF> __device__ __forceinline__ s16x4 tr_read(int vb) { s16x4 r; asm volatile("ds_read_b64_tr_b16 %0, %1 offset:%2" : "=&v"(r) : "v"(vb), "i"(OFF) : "memory"); return r; }
template <int D0> __device__ __forceinline__ void pv_one(f32x16& od, int vb, bf16x8 pa0, bf16x8 pa1, bf16x8 pa2, bf16x8 pa3) {
    const s16x4 l0 = tr_read<v_rd_off(D0, 0, 0)>(vb), h0 = tr_read<v_rd_off(D0, 0, 1)>(vb), l1 = tr_read<v_rd_off(D0, 1, 0)>(vb), h1 = tr_read<v_rd_off(D0, 1, 1)>(vb);
    const s16x4 l2 = tr_read<v_rd_off(D0, 2, 0)>(vb), h2 = tr_read<v_rd_off(D0, 2, 1)>(vb), l3 = tr_read<v_rd_off(D0, 3, 0)>(vb), h3 = tr_read<v_rd_off(D0, 3, 1)>(vb);
    asm volatile("s_waitcnt lgkmcnt(0)" ::: "memory"); SBAR();
#define PK(L, H) (bf16x8){L[0], L[1], L[2], L[3], H[0], H[1], H[2], H[3]}
    od = __builtin_amdgcn_mfma_f32_32x32x16_bf16(pa0, PK(l0, h0), od, 0, 0, 0);
    od = __builtin_amdgcn_mfma_f32_32x32x16_bf16(pa1, PK(l1, h1), od, 0, 0, 0);
    od = __builtin_amdgcn_mfma_f32_32x32x16_bf16(pa2, PK(l2, h2), od, 0, 0, 0);
    od = __builtin_amdgcn_mfma_f32_32x32x16_bf16(pa3, PK(l3, h3), od, 0, 0, 0);
#undef PK
}
__device__ __forceinline__ void pv_d0(f32x16* o, int vb, bf16x8 pa0, bf16x8 pa1, bf16x8 pa2, bf16x8 pa3) {
    pv_one<0>(o[0], vb, pa0, pa1, pa2, pa3); pv_one<1>(o[1], vb, pa0, pa1, pa2, pa3);
}
__device__ __forceinline__ int krow(int b, int T) { return T < 128 ? b * SEQ + 64 * T : MLAT + NCTX * b + 64 * (T - 128); }
__device__ __forceinline__ void attn_unit(const bf16* __restrict__ Qb, const bf16* __restrict__ Kh, const bf16* __restrict__ Vh, bf16* __restrict__ Ob, int b, int t_begin, int NT, char* lds, const int tid) {
    const int wid = tid >> 6, lane = tid & 63, r32 = lane & 31, hi = lane >> 5;
    char* V_lds = lds + LDS_V; char* K_lds = lds + LDS_K;
    float* ws = (float*)(lds + LDS_WS) + wid * 64; float* li_l = ws; float* al_l = ws + 32;
    float m_reg = -1e30f, l_reg = 0; f32x16 o[2] = {}; bf16x8 qr[6];
    const bf16* Qw = Qb + (long)(wid * QBLK + r32) * 768 + hi * 8;
#pragma unroll
    for (int d0 = 0; d0 < 6; ++d0) qr[d0] = *reinterpret_cast<const bf16x8*>(Qw + d0 * 16);
    const bool kst = wid < 6;
    const int sr = tid / 12, scK = (tid % 12) * 8, vr = tid >> 3, scV = (tid & 7) * 8;
    const int kw0 = KSWZ(sr, scK * 2), kw1 = KSWZ(32 + sr, scK * 2), vw = v_st(vr, scV);
    const int vb0 = (int)(uintptr_t)V_lds + v_rd_base(lane);
    struct { bf16x8 vs0, ks0, ks1; } sr_[2];
#define SLOAD(i, t) do { sr_[i].vs0 = *reinterpret_cast<const bf16x8*>(&Vh[((long)(t_begin + (t)) * 64 + vr) * 64 + scV]); \
    if (kst) { const long kt_ = (long)(t_begin + (t)) * 64; sr_[i].ks0 = *reinterpret_cast<const bf16x8*>(&Kh[(kt_ + sr) * 96 + scK]); sr_[i].ks1 = *reinterpret_cast<const bf16x8*>(&Kh[(kt_ + 32 + sr) * 96 + scK]); } } while (0)
#define SWRITE(bb, i) do { *(bf16x8*)(V_lds + (bb) * SHM_V + vw) = sr_[i].vs0; \
    if (kst) { *(bf16x8*)(K_lds + (bb) * SHM_K + kw0) = sr_[i].ks0; *(bf16x8*)(K_lds + (bb) * SHM_K + kw1) = sr_[i].ks1; } } while (0)
#define RESC(a) do { if (__any((a) < 1.f)) { if (hi == 0) al_l[r32] = (a); asm volatile("s_waitcnt lgkmcnt(0)" ::: "memory"); \
    _Pragma("unroll") for (int d = 0; d < 2; ++d) _Pragma("unroll") for (int r = 0; r < 16; ++r) o[d][r] *= al_l[crow(r, hi)]; } } while (0)
    f32x16 pA0, pA1, pB0, pB1; float mnA, mnB, alA, alB; bf16x8 pa0, pa1, pa2, pa3;
    constexpr int SE = 0, SO = 1;
    SLOAD(SE, 0); SWRITE(0, SE); __syncthreads();
    qkt(pA0, pA1, K_lds, qr, r32, hi); partialSM(pA0, pA1, m_reg, mnA, alA);
    SLOAD(SO, 1); if (2 < NT) SLOAD(SE, 2);
    SWRITE(1, SO); __syncthreads();
    for (int j = 1; j + 1 < NT; j += 2) {
        SBAR(); qkt(pB0, pB1, K_lds + SHM_K, qr, r32, hi);
        finishSM(pA0, pA1, alA, l_reg, pa0, pa1, pa2, pa3); SBAR();
        SLOAD(SO, j + 2); SBAR();
        pv_d0(o, vb0, pa0, pa1, pa2, pa3); partialSM(pB0, pB1, m_reg, mnB, alB);
        __syncthreads(); SWRITE(0, SE);
        RESC(alB); __syncthreads();
        SBAR(); qkt(pA0, pA1, K_lds, qr, r32, hi);
        finishSM(pB0, pB1, alB, l_reg, pa0, pa1, pa2, pa3); SBAR();
        if (j + 3 < NT) SLOAD(SE, j + 3); SBAR();
        pv_d0(o, vb0 + SHM_V, pa0, pa1, pa2, pa3); partialSM(pA0, pA1, m_reg, mnA, alA);
        __syncthreads(); SWRITE(1, SO);
        RESC(alA); __syncthreads();
    }
    SBAR(); qkt(pB0, pB1, K_lds + SHM_K, qr, r32, hi);
    finishSM(pA0, pA1, alA, l_reg, pa0, pa1, pa2, pa3); SBAR();
    pv_d0(o, vb0, pa0, pa1, pa2, pa3); partialSM(pB0, pB1, m_reg, mnB, alB);
    __syncthreads(); RESC(alB);
    finishSM(pB0, pB1, alB, l_reg, pa0, pa1, pa2, pa3); SBAR();
    pv_d0(o, vb0 + SHM_V, pa0, pa1, pa2, pa3);
    if (hi == 0) li_l[r32] = l_reg; asm volatile("s_waitcnt lgkmcnt(0)" ::: "memory");
    float rli[16];
#pragma unroll
    for (int r = 0; r < 16; ++r) rli[r] = __builtin_amdgcn_rcpf(li_l[crow(r, hi)]);
    bf16* Ow = Ob + (long)(wid * QBLK) * 512;
#pragma unroll
    for (int r = 0; r < 16; ++r) { const int orow = crow(r, hi);
#pragma unroll
        for (int d0 = 0; d0 < 2; ++d0) Ow[(long)orow * 512 + d0 * 32 + r32] = (bf16)(pk2(o[d0][r] * rli[r], 0.f) & 0xffffu); }
    __syncthreads();
#undef SLOAD
#undef SWRITE
#undef RESC
}

__device__ __forceinline__ s16x4 vtr(const LAS char* p) { typedef short v4i16_t __attribute__((ext_vector_type(4))); return __builtin_bit_cast(s16x4, __builtin_amdgcn_ds_read_tr16_b64_v4i16((LAS v4i16_t*)p)); }
__device__ __forceinline__ void qkt_fs(f32x16& p0, f32x16& p1, const LAS char* Ks, const bf16x8* qr, const f32x16& negb, int r32, int hi) {
#pragma unroll
    for (int d0 = 0; d0 < 6; ++d0) { const int cb = (d0 * 16 + hi * 8) * 2;
        const bf16x8 b0 = *(const LAS bf16x8*)(Ks + KSWZ(r32, cb));
        const bf16x8 b1 = *(const LAS bf16x8*)(Ks + KSWZ(32 + r32, cb));
        p0 = __builtin_amdgcn_mfma_f32_32x32x16_bf16(b0, qr[d0], d0 == 0 ? f32x16{} : p0, 0, 0, 0);
        p1 = __builtin_amdgcn_mfma_f32_32x32x16_bf16(b1, qr[d0], d0 == 0 ? f32x16{} : p1, 0, 0, 0); }
}
__device__ __forceinline__ void expack(f32x16& p0, f32x16& p1, bf16x8& pa0, bf16x8& pa1, bf16x8& pa2, bf16x8& pa3, float& l_reg) {
#pragma unroll
    for (int r = 0; r < 16; ++r) p0[r] = __builtin_amdgcn_exp2f(p0[r]);
#pragma unroll
    for (int r = 0; r < 16; ++r) p1[r] = __builtin_amdgcn_exp2f(p1[r]);
    { f32x2 s0 = {0.f, 0.f}, s1 = {0.f, 0.f};
#pragma unroll
      for (int r = 0; r < 16; r += 2) { s0 += (f32x2){p0[r], p0[r + 1]}; s1 += (f32x2){p1[r], p1[r + 1]}; }
      s0 += s1; l_reg += s0.x + s0.y; }
#define PK4(P, BASE, OUT) do { u32x4 w = {pk2(P[BASE + 0], P[BASE + 1]), pk2(P[BASE + 2], P[BASE + 3]), pk2(P[BASE + 4], P[BASE + 5]), pk2(P[BASE + 6], P[BASE + 7])}; OUT = __builtin_bit_cast(bf16x8, w); } while (0)
    PK4(p0, 0, pa0); PK4(p0, 8, pa1); PK4(p1, 0, pa2); PK4(p1, 8, pa3);
#undef PK4
}
__device__ __forceinline__ void pv3(f32x16* o, const LAS char* vp, bf16x8 pa0, bf16x8 pa1, bf16x8 pa2, bf16x8 pa3) {
#define PK(L, H) (bf16x8){L[0], L[1], L[2], L[3], H[0], H[1], H[2], H[3]}
#define PVK(ks, pa) do { const s16x4 l0 = vtr(vp + (ks) * 2048), h0 = vtr(vp + (ks) * 2048 + 256), l1 = vtr(vp + (ks) * 2048 + 512), h1 = vtr(vp + (ks) * 2048 + 512 + 256); \
    o[0] = __builtin_amdgcn_mfma_f32_32x32x16_bf16(pa, PK(l0, h0), o[0], 0, 0, 0); o[1] = __builtin_amdgcn_mfma_f32_32x32x16_bf16(pa, PK(l1, h1), o[1], 0, 0, 0); } while (0)
    PVK(0, pa0); PVK(1, pa1); PVK(2, pa2); PVK(3, pa3);
#undef PVK
#undef PK
}
__device__ __forceinline__ void attn_unit_fs(const bf16* __restrict__ Qb, const bf16* __restrict__ Kh, const bf16* __restrict__ Vh, bf16* __restrict__ Ob, int b, int t_begin, int NT, LAS char* lds, const int tid, const float bl2) {
    const int wid = tid >> 6, lane = tid & 63, r32 = lane & 31, hi = lane >> 5;
    LAS char* V_lds = lds + LDS_V; LAS char* K_lds = lds + LDS_K;
    f32x16 o[2] = {}; float l_reg = 0.f; bf16x8 qr[6]; const f32x16 negb = {};
    const bf16* Qw = Qb + (long)(wid * QBLK + r32) * 768 + hi * 8;
#pragma unroll
    for (int d0 = 0; d0 < 6; ++d0) qr[d0] = *reinterpret_cast<const bf16x8*>(Qw + d0 * 16);
    const bool kst = wid < 6;
    const int sr = tid / 12, scK = (tid % 12) * 8, vr = tid >> 3, scV = (tid & 7) * 8;
    const int kw0 = KSWZ(sr, scK * 2), kw1 = KSWZ(32 + sr, scK * 2), vw = v_st(vr, scV);
    const LAS char* vp0 = V_lds + (((lane & 3) << 3) | (((lane >> 2) & 3) << 6) | (((lane >> 4) & 1) << 5)) + hi * 1024;
    bf16x8 ks0, ks1, vs0;
    const unsigned kofB = (unsigned)(sr * 96 + scK) * 2u, vofB = (unsigned)(vr * 64 + scV) * 2u;
#define LDK(t) do { if (kst) { const int t_ = (t) < NT ? (t) : NT - 1; const char* kb_ = (const char*)Kh + (size_t)(t_begin + t_) * (64 * 192); \
    ks0 = *reinterpret_cast<const bf16x8*>(kb_ + kofB); ks1 = *reinterpret_cast<const bf16x8*>(kb_ + 32 * 192 + kofB); } } while (0)
#define LDV(t) do { const int t_ = (t) < NT ? (t) : NT - 1; const char* vb_ = (const char*)Vh + (size_t)(t_begin + t_) * (64 * 128); vs0 = *reinterpret_cast<const bf16x8*>(vb_ + vofB); } while (0)
#define WRK(bb) do { if (kst) { *(LAS bf16x8*)(K_lds + (bb) * SHM_K + kw0) = ks0; *(LAS bf16x8*)(K_lds + (bb) * SHM_K + kw1) = ks1; } } while (0)
#define WRV(bb) do { *(LAS bf16x8*)(V_lds + (bb) * SHM_V + vw) = vs0; } while (0)
    bf16x8 pa0, pa1, pa2, pa3;
    if (wid < 4) {
        f32x16 pA0, pA1, pB0, pB1;
        LDK(0); LDV(0); WRK(0); LDK(1); __syncthreads();
        qkt_fs(pA0, pA1, K_lds, qr, negb, r32, hi); WRK(1); WRV(0); LDK(2); LDV(1); __syncthreads();
        for (int j = 1; j + 1 < NT; j += 2) {
            qkt_fs(pB0, pB1, K_lds + SHM_K, qr, negb, r32, hi); expack(pA0, pA1, pa0, pa1, pa2, pa3, l_reg);
            pv3(o, vp0, pa0, pa1, pa2, pa3); WRK(0); WRV(1); LDK(j + 2); LDV(j + 1); __syncthreads();
            qkt_fs(pA0, pA1, K_lds, qr, negb, r32, hi); expack(pB0, pB1, pa0, pa1, pa2, pa3, l_reg);
            pv3(o, vp0 + SHM_V, pa0, pa1, pa2, pa3); WRK(1); WRV(0); LDK(j + 3); LDV(j + 2); __syncthreads();
        }
        qkt_fs(pB0, pB1, K_lds + SHM_K, qr, negb, r32, hi); expack(pA0, pA1, pa0, pa1, pa2, pa3, l_reg);
        pv3(o, vp0, pa0, pa1, pa2, pa3); WRV(1); __syncthreads();
        expack(pB0, pB1, pa0, pa1, pa2, pa3, l_reg);
        pv3(o, vp0 + SHM_V, pa0, pa1, pa2, pa3);
    } else {
        f32x16 p0, p1;
        LDK(0); LDV(0); WRK(0); LDK(1); __syncthreads();
        qkt_fs(p0, p1, K_lds, qr, negb, r32, hi); expack(p0, p1, pa0, pa1, pa2, pa3, l_reg); WRK(1); WRV(0); LDK(2); LDV(1); __syncthreads();
        for (int j = 1; j + 1 < NT; j += 2) {
            pv3(o, vp0, pa0, pa1, pa2, pa3);
            qkt_fs(p0, p1, K_lds + SHM_K, qr, negb, r32, hi); expack(p0, p1, pa0, pa1, pa2, pa3, l_reg);
            WRK(0); WRV(1); LDK(j + 2); LDV(j + 1); __syncthreads();
            pv3(o, vp0 + SHM_V, pa0, pa1, pa2, pa3);
            qkt_fs(p0, p1, K_lds, qr, negb, r32, hi); expack(p0, p1, pa0, pa1, pa2, pa3, l_reg);
            WRK(1); WRV(0); LDK(j + 3); LDV(j + 2); __syncthreads();
        }
        pv3(o, vp0, pa0, pa1, pa2, pa3);
        qkt_fs(p0, p1, K_lds + SHM_K, qr, negb, r32, hi); expack(p0, p1, pa0, pa1, pa2, pa3, l_reg);
        WRV(1); __syncthreads();
        pv3(o, vp0 + SHM_V, pa0, pa1, pa2, pa3);
    }
    { auto rr = __builtin_amdgcn_permlane32_swap(__float_as_uint(l_reg), __float_as_uint(l_reg), false, false); l_reg = __uint_as_float(rr[0]) + __uint_as_float(rr[1]); }
    LAS float* li_l = (LAS float*)(lds + LDS_WS) + wid * 64;
    if (hi == 0) li_l[r32] = l_reg;
    bf16* Ow = Ob + (long)(wid * QBLK) * 512;
#pragma unroll
    for (int r = 0; r < 16; ++r) { const int orow = crow(r, hi); const float rl = __builtin_amdgcn_rcpf(li_l[orow]);
#pragma unroll
        for (int d0 = 0; d0 < 2; ++d0) Ow[(long)orow * 512 + d0 * 32 + r32] = (bf16)(pk2(o[d0][r] * rl, 0.f) & 0xffffu); }
    __syncthreads();
#undef LDK
#undef LDV
#undef WRK
#undef WRV
}

typedef f32x4 acc4;
#define MF16(a_, b_, c_) __builtin_amdgcn_mfma_f32_16x16x32_bf16(a_, b_, c_, 0, 0, 0)
__device__ __forceinline__ void qkt16(acc4 (&s)[2][4], const LAS char* Ks, int kb0, int kb1, const bf16x8 (&qf)[2][3]) {
    const acc4 z4 = {0.f, 0.f, 0.f, 0.f};
#pragma unroll
    for (int ks = 0; ks < 3; ++ks)
#pragma unroll
        for (int kg = 0; kg < 4; ++kg) { const bf16x8 kf = *(const LAS bf16x8*)(Ks + ((ks & 1) ? kb1 : kb0) + kg * 4096 + (ks >> 1) * 128);
#pragma unroll
            for (int a = 0; a < 2; ++a) s[a][kg] = MF16(kf, qf[a][ks], ks == 0 ? z4 : s[a][kg]); }
}
__device__ __forceinline__ void expack16(acc4 (&s)[2][4], bf16x8 (&pa)[2][2], float (&l)[2]) {
#pragma unroll
    for (int a = 0; a < 2; ++a) { f32x2 t0 = {0.f, 0.f}, t1 = {0.f, 0.f};
#pragma unroll
        for (int kg = 0; kg < 4; ++kg) {
#pragma unroll
            for (int r = 0; r < 4; ++r) s[a][kg][r] = __builtin_amdgcn_exp2f(s[a][kg][r]);
            t0 += (f32x2){s[a][kg][0], s[a][kg][1]}; t1 += (f32x2){s[a][kg][2], s[a][kg][3]}; }
        t0 += t1; l[a] += t0.x + t0.y;
#pragma unroll
        for (int kb = 0; kb < 2; ++kb) { const acc4 u = s[a][2 * kb], v = s[a][2 * kb + 1];
            u32x4 w = {pk2(u[0], u[1]), pk2(u[2], u[3]), pk2(v[0], v[1]), pk2(v[2], v[3])}; pa[a][kb] = __builtin_bit_cast(bf16x8, w); } }
}
__device__ __forceinline__ void pv16(acc4 (&o)[4][2], const LAS char* vp, const bf16x8 (&pa)[2][2]) {
#pragma unroll
    for (int kb = 0; kb < 2; ++kb)
#pragma unroll
        for (int dg = 0; dg < 4; ++dg) { const LAS char* p = vp + kb * 4096 + (dg >> 1) * 512 + (dg & 1) * 32;
            const s16x4 lo = vtr(p), hi = vtr(p + 2048); const bf16x8 vf = {lo[0], lo[1], lo[2], lo[3], hi[0], hi[1], hi[2], hi[3]};
#pragma unroll
            for (int a = 0; a < 2; ++a) o[dg][a] = MF16(vf, pa[a][kb], o[dg][a]); }
}
__device__ __forceinline__ void attn_unit_m16(const bf16* __restrict__ Qb, const bf16* __restrict__ Kh, const bf16* __restrict__ Vh, bf16* __restrict__ Ob, int t_begin, int NT, LAS char* lds, const int tid) {
    const int wid = tid >> 6, lane = tid & 63, g = lane >> 4, j = lane & 15;
    LAS char* V_lds = lds; LAS char* K_lds = lds + 3 * SHM_V;
    acc4 o[4][2]; float l[2] = {0.f, 0.f}; bf16x8 qf[2][3];
#pragma unroll
    for (int dg = 0; dg < 4; ++dg)
#pragma unroll
        for (int a = 0; a < 2; ++a) o[dg][a] = (acc4){0.f, 0.f, 0.f, 0.f};
#pragma unroll
    for (int a = 0; a < 2; ++a)
#pragma unroll
        for (int ks = 0; ks < 3; ++ks) qf[a][ks] = *reinterpret_cast<const bf16x8*>(Qb + (long)(wid * QBLK + 16 * a + j) * 768 + 32 * ks + 8 * g);
    const int tl = tid & 255, idH0 = tl, idH1 = tl + 256, idL = tl + 512;
    const int vr = tid >> 3, scV = (tid & 7) * 8;
    const int kwH0 = KSWZ(idH0 / 12, (idH0 % 12) * 16), kwH1 = KSWZ(idH1 / 12, (idH1 % 12) * 16), kwL = KSWZ(idL / 12, (idL % 12) * 16), vw = v_st(vr, scV);
    const int kb0 = j * 256 + ((g ^ (j & 7)) * 16), kb1 = j * 256 + (((4 | g) ^ (j & 7)) * 16);
    const LAS char* vp0 = V_lds + (g & 1) * 1024 + ((((lane >> 2) & 3) + 4 * (g >> 1)) * 64) + (lane & 3) * 8;
    bf16x8 ks0_0, ks1_0, vs0_0, ks0_1, ks1_1, vs0_1;
    const unsigned kofH0 = (unsigned)idH0 * 16u, kofH1 = (unsigned)idH1 * 16u, kofL = (unsigned)idL * 16u, vofB = (unsigned)(vr * 64 + scV) * 2u;
#define LDK(t, P, S) do { const int t_ = (t) < NT ? (t) : NT - 1; const char* kb_ = (const char*)Kh + (size_t)(t_begin + t_) * (64 * 192); \
    if (HALF == (P)) { ks0_##S = *reinterpret_cast<const bf16x8*>(kb_ + kofH0); ks1_##S = *reinterpret_cast<const bf16x8*>(kb_ + kofH1); } else ks0_##S = *reinterpret_cast<const bf16x8*>(kb_ + kofL); } while (0)
#define LDV(t, S) do { const int t_ = (t) < NT ? (t) : NT - 1; const char* vb_ = (const char*)Vh + (size_t)(t_begin + t_) * (64 * 128); vs0_##S = *reinterpret_cast<const bf16x8*>(vb_ + vofB); } while (0)
#define WRK(bb, S) do { if (HALF == (bb)) { *(LAS bf16x8*)(K_lds + (bb) * SHM_K + kwH0) = ks0_##S; *(LAS bf16x8*)(K_lds + (bb) * SHM_K + kwH1) = ks1_##S; } else *(LAS bf16x8*)(K_lds + (bb) * SHM_K + kwL) = ks0_##S; } while (0)
#define WRV(off, S) do { *(LAS bf16x8*)(V_lds + (off) + vw) = vs0_##S; } while (0)
#define VROT() do { vprev = vcur; vcur = (vcur == 2 * SHM_V) ? 0 : vcur + SHM_V; } while (0)
#define A_BODY() do { acc4 pA[2][4], pB[2][4]; int vcur = 0, vprev = 0; \
        LDK(0, 0, 0); WRK(0, 0); LDK(1, 1, 0); LDV(0, 0); LDK(2, 0, 1); LDV(1, 1); __syncthreads(); \
        qkt16(pA, K_lds, kb0, kb1, qf); WRK(1, 0); WRV(vcur, 0); LDK(3, 1, 0); LDV(2, 0); __syncthreads(); VROT(); \
        for (int jt = 1; jt + 1 < NT; jt += 2) { \
            qkt16(pB, K_lds + SHM_K, kb0, kb1, qf); WRK(0, 1); WRV(vcur, 1); LDK(jt + 3, 0, 1); LDV(jt + 2, 1); expack16(pA, pa, l); __syncthreads(); \
            pv16(o, vp0 + vprev, pa); VROT(); \
            qkt16(pA, K_lds, kb0, kb1, qf); WRK(1, 0); WRV(vcur, 0); LDK(jt + 4, 1, 0); LDV(jt + 3, 0); expack16(pB, pa, l); __syncthreads(); \
            pv16(o, vp0 + vprev, pa); VROT(); \
        } \
        qkt16(pB, K_lds + SHM_K, kb0, kb1, qf); WRV(vcur, 1); expack16(pA, pa, l); __syncthreads(); \
        pv16(o, vp0 + vprev, pa); VROT(); \
        expack16(pB, pa, l); \
        pv16(o, vp0 + vprev, pa); } while (0)
    bf16x8 pa[2][2];
    if (wid < 4) { constexpr int HALF = 0; A_BODY(); }
    else { constexpr int HALF = 1; A_BODY(); }
#pragma unroll
    for (int a = 0; a < 2; ++a) { float t = l[a]; t += __shfl_xor(t, 16); t += __shfl_xor(t, 32); const float rl = __builtin_amdgcn_rcpf(t);
        bf16* orow = Ob + (long)(wid * QBLK + 16 * a + j) * 512 + 4 * g;
#pragma unroll
        for (int dg = 0; dg < 4; ++dg) { u32x2 w = {pk2(o[dg][a][0] * rl, o[dg][a][1] * rl), pk2(o[dg][a][2] * rl, o[dg][a][3] * rl)}; *(u32x2*)(orow + 16 * dg) = w; } }
    __syncthreads();
#undef LDK
#undef LDV
#undef WRK
#undef WRV
#undef VROT
#undef A_BODY
}
#undef MF16
#undef SBAR
}

#define XB_TMO      128
#define XB_XCNT(j)  (256  + 64 * (j))
#define XB_XSUB(j)  (1280 + 64 * (j))
#define XB_XGEN(j)  (2304 + 64 * (j))
#define XB_TOP      3328
#define XB_TOPGEN   3392
#define XCD_BAR_WORDS 3456
#define XB_SPIN_CAP (1u << 18)
__device__ __forceinline__ unsigned xb_ld(unsigned* p)              { return __hip_atomic_load(p, __ATOMIC_RELAXED, __HIP_MEMORY_SCOPE_AGENT); }
__device__ __forceinline__ unsigned xb_add(unsigned* p, unsigned v) { return __hip_atomic_fetch_add(p, v, __ATOMIC_RELAXED, __HIP_MEMORY_SCOPE_AGENT); }
__device__ __forceinline__ unsigned xb_xcc_id() { return (unsigned)__builtin_amdgcn_s_getreg((3 << 11) | 20) & 0xFu; }
#define XB_SPIN(cond, bar) do { unsigned _sp = 0; while (cond) { __builtin_amdgcn_s_sleep(1); \
    if ((++_sp & 255u) == 0u) { if (xb_ld(&(bar)[XB_TMO])) break; if (_sp > XB_SPIN_CAP) { atomicAdd(&(bar)[XB_TMO], 1u); break; } } } } while (0)
struct XcdBarrier { unsigned* bar; unsigned x; volatile LAS unsigned* st; };
__device__ __forceinline__ void xcd_barrier_complete(unsigned* bar, unsigned x, unsigned& nloc, unsigned& nx) {
    const unsigned G = gridDim.x * gridDim.y * gridDim.z;
    unsigned sum, cnt, mine, sp = 0u;
    for (;;) {
        sum = 0u; cnt = 0u; mine = 0u;
#pragma unroll
        for (unsigned j = 0; j < 16; ++j) { const unsigned c = xb_ld(&bar[XB_XCNT(j)]); sum += c; cnt += (c > 0u) ? 1u : 0u; mine = (j == x) ? c : mine; }
        if (sum == G) break;
        __builtin_amdgcn_s_sleep(1);
        if ((++sp & 255u) == 0u) { if (xb_ld(&bar[XB_TMO])) break; if (sp > XB_SPIN_CAP) { atomicAdd(&bar[XB_TMO], 1u); break; } }
    }
    nloc = mine > 0u ? mine : 1u; nx = cnt > 0u ? cnt : 1u;
}
__device__ __forceinline__ void xcd_barrier(const XcdBarrier& b) {
    asm volatile("s_waitcnt vmcnt(0)" ::: "memory");
    __syncthreads();
    if (threadIdx.x == 0) {
        unsigned* bar = b.bar;
        __builtin_amdgcn_s_waitcnt(0);
        unsigned nloc = b.st[0], nx = b.st[1];
        if (nloc == 0u) { xcd_barrier_complete(bar, b.x, nloc, nx); b.st[0] = nloc; b.st[1] = nx; }
        const unsigned old = xb_add(&bar[XB_XSUB(b.x)], 1u);
        const unsigned gen = old / nloc;
        if (old + 1u == (gen + 1u) * nloc) {
            __builtin_amdgcn_fence(__ATOMIC_RELEASE, "agent");
            asm volatile("s_waitcnt vmcnt(0)" ::: "memory");
            const unsigned og = xb_add(&bar[XB_TOP], 1u);
            const unsigned tg = og / nx;
            if (og + 1u == (tg + 1u) * nx) xb_add(&bar[XB_TOPGEN], 1u);
            else XB_SPIN(xb_ld(&bar[XB_TOPGEN]) == tg, bar);
            __builtin_amdgcn_fence(__ATOMIC_ACQUIRE, "agent");
            xb_add(&bar[XB_XGEN(b.x)], 1u);
            asm volatile("s_waitcnt vmcnt(0)" ::: "memory");
        } else {
            XB_SPIN(xb_ld(&bar[XB_XGEN(b.x)]) == gen, bar);
            __builtin_amdgcn_fence(__ATOMIC_ACQUIRE, "agent");
            asm volatile("s_waitcnt vmcnt(0)" ::: "memory");
        }
    }
    __syncthreads();
}

constexpr int LDS_BYTES = 147456;
constexpr int NPH_LAYER = 13 + (REPK >= 0 ? 1 : 0), NPHASES = 1 + 2 * NPH_LAYER;
struct Args { const float* in[26]; float* out; unsigned char* ws; int ph_lo, ph_hi; };

__device__ __forceinline__ void transpose_item(const float* W, int K, int Nsrc, bf16* WT, int Ndst, int mode, const float* rowscale, LAS float* scr, int item, int lane) {
    const int nblk = Ndst / 32, kb = item / nblk, nb = item % nblk, k0 = 64 * kb, n0 = 32 * nb;
    int src = n0; bool zero = false;
    if (mode == 1) src = ((n0 >> 7) & 1) * DFF + (n0 >> 8) * 128 + (n0 & 127); else zero = n0 >= Nsrc;
    f32x4 v[8];
#pragma unroll
    for (int i = 0; i < 8; ++i) { const int kk = 8 * i + (lane >> 3);
        v[i] = zero ? (f32x4){0.f, 0.f, 0.f, 0.f} : *(const f32x4*)(W + (size_t)(k0 + kk) * Nsrc + src + 4 * (lane & 7));
        if (rowscale) v[i] = v[i] * rowscale[k0 + kk]; }
#pragma unroll
    for (int i = 0; i < 8; ++i) { const int kk = 8 * i + (lane >> 3); LAS float* d = scr + kk * 33 + 4 * (lane & 7); d[0] = v[i].x; d[1] = v[i].y; d[2] = v[i].z; d[3] = v[i].w; }
    asm volatile("s_waitcnt lgkmcnt(0)" ::: "memory");
    const int c = lane & 7;
#pragma unroll
    for (int j = 0; j < 4; ++j) { const int n = (lane >> 3) + 8 * j; const LAS float* s = scr + (8 * c) * 33 + n;
        u32x4 o; o.x = pk2(s[0 * 33], s[1 * 33]); o.y = pk2(s[2 * 33], s[3 * 33]); o.z = pk2(s[4 * 33], s[5 * 33]); o.w = pk2(s[6 * 33], s[7 * 33]);
        *(u32x4*)(WT + (size_t)(n0 + n) * K + k0 + 8 * c) = o; }
    asm volatile("s_waitcnt lgkmcnt(0)" ::: "memory");
}
__device__ __forceinline__ void sincos_d(double x, double& s, double& c) {
    const double k = __builtin_rint(x * 0.6366197723675814);
    double r = __builtin_fma(-k, 1.5707963267948966, x); r = __builtin_fma(-k, 6.123233995736766e-17, r);
    const double r2 = r * r;
    double sp = 1.0 / 6227020800.0; sp = sp * r2 - 1.0 / 39916800.0; sp = sp * r2 + 1.0 / 362880.0; sp = sp * r2 - 1.0 / 5040.0; sp = sp * r2 + 1.0 / 120.0; sp = sp * r2 - 1.0 / 6.0; sp = sp * r2 + 1.0; sp *= r;
    double cp = -1.0 / 87178291200.0; cp = cp * r2 + 1.0 / 479001600.0; cp = cp * r2 - 1.0 / 3628800.0; cp = cp * r2 + 1.0 / 40320.0; cp = cp * r2 - 1.0 / 720.0; cp = cp * r2 + 1.0 / 24.0; cp = cp * r2 - 0.5; cp = cp * r2 + 1.0;
    const int n = ((int)k) & 3;
    s = (n == 0) ? sp : (n == 1) ? cp : (n == 2) ? -sp : -cp;
    c = (n == 0) ? cp : (n == 1) ? -sp : (n == 2) ? -cp : sp;
}

__global__ void __launch_bounds__(512, 2) mk_fwd(Args args) {
    extern __shared__ __attribute__((aligned(16))) unsigned char lds_raw[];
    LAS unsigned char* lds = (LAS unsigned char*)lds_raw;
    cg::grid_group grid = cg::this_grid();
    const int ph_lo = args.ph_lo, ph_hi = args.ph_hi;
    volatile LAS unsigned* MISC = (volatile LAS unsigned*)(lds + 131072 + 64);
    if (threadIdx.x < 4) MISC[threadIdx.x] = 0u;
    __syncthreads();
    if (!MK_MULTI && threadIdx.x == 0) (void)xb_add(&((unsigned*)(args.ws + WS_CTL))[XB_XCNT(xb_xcc_id())], 1u);
    if (!MK_MULTI && ph_hi > 1) grid.sync();
    typedef const float* __attribute__((address_space(4))) const* in_tab_t;

    if (ph_lo == 0 && PHEN(0)) {
        int tid = threadIdx.x; asm volatile("" : "+v"(tid));
        int bx = blockIdx.x; asm volatile("" : "+s"(bx));
        const unsigned char __attribute__((address_space(4)))* kp = (const unsigned char __attribute__((address_space(4)))*)__builtin_amdgcn_kernarg_segment_ptr(); asm volatile("" : "+s"(kp));
        struct InTab { in_tab_t p; __device__ __forceinline__ const float* operator[](int i) const { return p[i]; } };
        struct ArgsV { InTab in; } args_v; args_v.in.p = (in_tab_t)kp;
#define args args_v
        float* out = *(float* const __attribute__((address_space(4)))*)(kp + 26 * 8);
        unsigned char* ws = *(unsigned char* const __attribute__((address_space(4)))*)(kp + 27 * 8);
        const int lane = tid & 63, wave = __builtin_amdgcn_readfirstlane(tid >> 6);
        const int G = gridDim.x, gw = bx * 8 + wave, NGW = G * 8;
        float* mod = (float*)(ws + WS_MOD); float* rope = (float*)(ws + WS_ROPE);
        float* HC = (float*)(ws + WS_HC); bf16* Abuf = (bf16*)(ws + WS_A);
        bf16* U = (bf16*)(ws + WS_R + R_U); bf16* MIX = (bf16*)(ws + WS_R + R_MIX); bf16* Obuf = (bf16*)(ws + WS_R + R_O);
        bf16* QRAW = (bf16*)(ws + WS_R + R_QRAW); bf16* KVRAW = (bf16*)(ws + WS_R + R_KVRAW); bf16* Kbuf = (bf16*)(ws + WS_R + R_K); bf16* Vbuf = (bf16*)(ws + WS_R + R_V);
        const float* x_in = args.in[0]; const float* ctx_in = args.in[2]; float* PART = (float*)(ws + WS_R + 200 * MiB);
            LAS float* scv = (LAS float*)lds;
            LAS float* red = (LAS float*)(lds + 20480);
            for (int i = tid; i < 5 * DM; i += 512) { const int s = i >> 10, k = i & 1023; const float v = s < 4 ? args.in[1][s * DM + k] : args.in[3][k]; scv[i] = fsilu(v); }
            __syncthreads();
            for (int chunk = bx; chunk < 288; chunk += G) {
                const int l = chunk / 144, n0 = (chunk % 144) * 64, kq = tid >> 4, cq = tid & 15;
                const float* wa = args.in[4] + (size_t)l * DM * ADA + n0 + 4 * cq;
                f32x4 acc[5];
#pragma unroll
                for (int s = 0; s < 5; ++s) acc[s] = (f32x4){0.f, 0.f, 0.f, 0.f};
#pragma unroll 4
                for (int i = 0; i < 32; ++i) { const int k = kq + 32 * i; const f32x4 w = *(const f32x4*)(wa + (size_t)k * ADA);
#pragma unroll
                    for (int s = 0; s < 5; ++s) acc[s] += w * scv[s * DM + k]; }
#pragma unroll
                for (int s = 0; s < 5; ++s)
#pragma unroll
                    for (int e = 0; e < 4; ++e) red[(kq * 5 + s) * 64 + 4 * cq + e] = acc[s][e];
                __syncthreads();
                if (tid < 320) { const int s = tid >> 6, col = tid & 63; float v = 0.f;
                    for (int q = 0; q < 32; ++q) v += red[(q * 5 + s) * 64 + col];
                    mod[(size_t)(l * 5 + s) * ADA + n0 + col] = v + args.in[5][l * ADA + n0 + col]; }
                __syncthreads();
            }
            { const int gt = bx * 512 + tid;
              if (gt < 1024) { const int pos = gt >> 3, j = gt & 7; const int e = j >> 1;
                  double base = (j & 1) ? 0.31622776601683794 : 1.0; base *= (e == 0 ? 1.0 : e == 1 ? 0.1 : e == 2 ? 0.01 : 0.001);
                  const float invf = (float)base; const float ang = (float)pos * invf; double s, c; sincos_d((double)ang, s, c);
                  rope[2 * gt] = (float)c; rope[2 * gt + 1] = (float)s; } }
            __syncthreads();
            for (int i = bx * 512 + tid; i < MCTX * DM / 4; i += G * 512) ((f32x4*)HC)[i] = ((const f32x4*)ctx_in)[i];
            LAS float* scr = (LAS float*)(lds + wave * 16384);
            constexpr int I_IN = 16 * 176, I_OUT = 44 * 32, I_MIX = 16 * 64, I_Q = 6 * 24, I_KV = 4 * 32, I_MO = 16 * 32;
            constexpr int I_LAYER = 2 * I_IN + 2 * I_OUT + I_MIX + I_Q + I_KV + I_MO;
            for (int it = gw; it < 2 * I_LAYER; it += NGW) {
                const int l = it / I_LAYER; int r = it % I_LAYER; unsigned char* wl = ws + WS_W + (size_t)l * W_LAYER;
                if (r < I_IN) { transpose_item(args.in[7] + (size_t)l * DM * 2 * DFF, DM, 2 * DFF, (bf16*)(wl + WO_FFN1IN), 2 * DFF, 1, nullptr, scr, r, lane); continue; } r -= I_IN;
                if (r < I_OUT) { transpose_item(args.in[8] + (size_t)l * DFF * DM, DFF, DM, (bf16*)(wl + WO_FFN1OUT), DM, 0, nullptr, scr, r, lane); continue; } r -= I_OUT;
                if (r < I_MIX) { transpose_item(args.in[10] + (size_t)l * DM * MIXN, DM, MIXN, (bf16*)(wl + WO_MIXIN), MIXP, 0, nullptr, scr, r, lane); continue; } r -= I_MIX;
                if (r < I_Q) { transpose_item(args.in[12] + (size_t)l * QLORA * 768, QLORA, 768, (bf16*)(wl + WO_QUP), 768, 0, args.in[11] + l * QLORA, scr, r, lane); continue; } r -= I_Q;
                if (r < I_KV) { transpose_item(args.in[14] + (size_t)l * KVLORA * 1024, KVLORA, 1024, (bf16*)(wl + WO_KVUP), 1024, 0, args.in[13] + l * KVLORA, scr, r, lane); continue; } r -= I_KV;
                if (r < I_MO) { transpose_item(args.in[22] + (size_t)l * DM * DM, DM, DM, (bf16*)(wl + WO_MIXOUT), DM, 0, nullptr, scr, r, lane); continue; } r -= I_MO;
                if (r < I_IN) { transpose_item(args.in[24] + (size_t)l * DM * 2 * DFF, DM, 2 * DFF, (bf16*)(wl + WO_FFN2IN), 2 * DFF, 1, nullptr, scr, r, lane); continue; } r -= I_IN;
                transpose_item(args.in[25] + (size_t)l * DFF * DM, DFF, DM, (bf16*)(wl + WO_FFN2OUT), DM, 0, nullptr, scr, r, lane);
            }
#undef args
        if (ph_hi > 1) { XcdBarrier xb; xb.bar = (unsigned*)(args.ws + WS_CTL); xb.x = xb_xcc_id(); xb.st = MISC; xcd_barrier(xb); }
    }
    for (int ph = (ph_lo < 1 ? 1 : ph_lo); ph < ph_hi; ++ph) {
        int tid = threadIdx.x; asm volatile("" : "+v"(tid));
        int bx = blockIdx.x; asm volatile("" : "+s"(bx));
        const unsigned char __attribute__((address_space(4)))* kp = (const unsigned char __attribute__((address_space(4)))*)__builtin_amdgcn_kernarg_segment_ptr(); asm volatile("" : "+s"(kp));
        struct InTab { in_tab_t p; __device__ __forceinline__ const float* operator[](int i) const { return p[i]; } };
        struct ArgsV { InTab in; } args_v; args_v.in.p = (in_tab_t)kp;
#define args args_v
        float* out = *(float* const __attribute__((address_space(4)))*)(kp + 26 * 8);
        unsigned char* ws = *(unsigned char* const __attribute__((address_space(4)))*)(kp + 27 * 8);
        const int lane = tid & 63, wave = __builtin_amdgcn_readfirstlane(tid >> 6);
        const int G = gridDim.x, gw = bx * 8 + wave, NGW = G * 8;
        float* mod = (float*)(ws + WS_MOD); float* rope = (float*)(ws + WS_ROPE);
        float* HC = (float*)(ws + WS_HC); bf16* Abuf = (bf16*)(ws + WS_A);
        bf16* U = (bf16*)(ws + WS_R + R_U); bf16* MIX = (bf16*)(ws + WS_R + R_MIX); bf16* Obuf = (bf16*)(ws + WS_R + R_O);
        bf16* QRAW = (bf16*)(ws + WS_R + R_QRAW); bf16* KVRAW = (bf16*)(ws + WS_R + R_KVRAW); bf16* Kbuf = (bf16*)(ws + WS_R + R_K); bf16* Vbuf = (bf16*)(ws + WS_R + R_V);
        const float* x_in = args.in[0]; const float* ctx_in = args.in[2]; float* PART = (float*)(ws + WS_R + 200 * MiB);
        {
            const int l = (ph - 1) / NPH_LAYER, slot = (ph - 1) % NPH_LAYER, k = (REPK >= 0 && slot > REPK) ? slot - 1 : slot; const bool last = (l == 1);
            unsigned char* wl = ws + WS_W + (size_t)l * W_LAYER; const float* modl = mod + (size_t)l * 5 * ADA;
            const float* h_lat = (l == 0 && k <= 2) ? x_in : out; const float* h_ctx = HC;
            if ((k == 0 || k == 3 || k == 10) && PHEN(1)) {
                const int ch = (k == 0) ? 0 : (k == 3) ? 3 : 6; const float* g = (k == 0 ? args.in[6] : k == 3 ? args.in[9] : args.in[23]) + l * DM;
                const int nrows = (k == 10 && last) ? MLAT : MTOT;
                const int nsp = (k == 0) ? (l == 1 ? 11 : 0) : (k == 3) ? 11 : (last ? 0 : 4);
#pragma unroll 2
                for (int row = gw; row < nrows; row += NGW) {
                    const bool lat = row < MLAT; const float* src = lat ? h_lat + (size_t)row * DM : h_ctx + (size_t)(row - MLAT) * DM; const int s = lat ? (row >> 13) : 4;
                    const float* sh = modl + (size_t)s * ADA + ch * DM; const float* sc = sh + DM;
                    f32x4 v[4]; float ss = 0.f;
#pragma unroll
                    for (int j = 0; j < 4; ++j) v[j] = *(const f32x4*)(src + 4 * lane + 256 * j);
                    if (!lat && nsp) {
                        for (int sp = 0; sp < nsp; ++sp) { const float* pr = PART + (size_t)sp * ((size_t)MCTX * DM) + (size_t)(row - MLAT) * DM + 4 * lane;
#pragma unroll
                            for (int j = 0; j < 4; ++j) v[j] += *(const f32x4*)(pr + 256 * j); }
#pragma unroll
                        for (int j = 0; j < 4; ++j) *(f32x4*)(HC + (size_t)(row - MLAT) * DM + 4 * lane + 256 * j) = v[j];
                    }
#pragma unroll
                    for (int j = 0; j < 4; ++j) ss += (v[j].x * v[j].x + v[j].y * v[j].y) + (v[j].z * v[j].z + v[j].w * v[j].w);
                    const float rstd = __builtin_amdgcn_rsqf(wave_sum(ss) * (1.f / DM) + EPS);
#pragma unroll
                    for (int j = 0; j < 4; ++j) { const int c = 4 * lane + 256 * j; const f32x4 gg = *(const f32x4*)(g + c), s1 = *(const f32x4*)(sc + c), s0 = *(const f32x4*)(sh + c);
                        const f32x4 o = v[j] * rstd * gg * (s1 + 1.f) + s0; u32x2 w; w.x = pk2(o.x, o.y); w.y = pk2(o.z, o.w); *(u32x2*)(Abuf + (size_t)row * DM + c) = w; }
                }
            } else if ((k == 1 || k == 11) && PHEN(2)) {
                pg8::Gemm g{Abuf, (const bf16*)(wl + (k == 1 ? WO_FFN1IN : WO_FFN2IN)), (k == 11 && last) ? MLAT : MTOT, 2 * DFF, DM, DM};
                pg8::StaticOrder S; S.init(g.M, g.N, g.K, G, bx); pg8::EpiSwiGLU E{U, DFF};
                pg8::gemm_phase<pg8::EpiSwiGLU>(lds, g, S, E, tid);
            } else if ((k == 2 || k == 9 || k == 12) && PHEN(3)) {
                const bf16* Bt = (const bf16*)(wl + (k == 2 ? WO_FFN1OUT : k == 9 ? WO_MIXOUT : WO_FFN2OUT));
                pg8::Gemm g{k == 9 ? Abuf : U, Bt, (k != 2 && last) ? MLAT : MTOT, DM, k == 9 ? DM : DFF, k == 9 ? DM : DFF};
                pg8::StaticOrder S; S.init(g.M, g.N, g.K, G, bx, g.M - MLAT, 4);
                pg8::EpiResid E{h_lat, HC, out, HC, modl + (k == 2 ? 2 : k == 9 ? 5 : 8) * DM, k == 9 ? 1.f : 0.5f, g.K / pg8::BK, PART};
                pg8::gemm_phase<pg8::EpiResid>(lds, g, S, E, tid);
            } else if (k == 4 && PHEN(4)) {
                pg8::Gemm g{Abuf, (const bf16*)(wl + WO_MIXIN), MTOT, MIXP, DM, DM};
                pg8::StaticOrder S; S.init(g.M, g.N, g.K, G, bx); pg8::EpiStore E{MIX, MIXP};
                pg8::gemm_phase<pg8::EpiStore>(lds, g, S, E, tid);
            } else if (k == 5 && PHEN(5)) {
                { pg8::Gemm g{MIX, (const bf16*)(wl + WO_QUP), last ? MLAT : MTOT, 768, QLORA, MIXP};
                  pg8::StaticOrder S; S.init(g.M, g.N, g.K, G, bx); pg8::EpiStore E{QRAW, 768};
                  pg8::gemm_phase<pg8::EpiStore>(lds, g, S, E, tid); }
                { pg8::Gemm g{MIX + OFF_KV, (const bf16*)(wl + WO_KVUP), MTOT, 1024, KVLORA, MIXP};
                  pg8::StaticOrder S; S.init(g.M, g.N, g.K, G, (bx + 116) % G); pg8::EpiStore E{KVRAW, 1024};
                  pg8::gemm_phase<pg8::EpiStore>(lds, g, S, E, tid); }
            } else if (k == 6 && PHEN(6)) {
                const float* g_out = args.in[21] + l * DM;
                const int nchunk = last ? MLAT / 128 : MTOT / 128;
                LAS bf16* vT = (LAS bf16*)lds;
                for (int ci = bx; ci < nchunk; ci += G) {
                    { const int q = tid >> 2, gI = tid & 3; const bf16* src = MIX + (size_t)(ci * 128 + q) * MIXP + OFF_SG + 256 + gI * 64;
                      float vv[64]; float ss = 0.f;
#pragma unroll
                      for (int i = 0; i < 8; ++i) { const u32x4 w = *(const u32x4*)(src + 8 * i);
#pragma unroll
                          for (int e = 0; e < 4; ++e) { const float a = fgelu(bflo(w[e])), b2 = fgelu(bfhi(w[e])); vv[8 * i + 2 * e] = a; vv[8 * i + 2 * e + 1] = b2; ss += a * a + b2 * b2; } }
                      const float rs = __builtin_amdgcn_rsqf(ss * (1.f / 64.f) + EPS); const float* gs = args.in[17] + l * 256 + gI * 64;
#pragma unroll
                      for (int c = 0; c < 64; ++c) vT[(gI * 64 + c) * 136 + q] = (bf16)(pk2(vv[c] * rs * gs[c], 0.f) & 0xffffu); }
                    __syncthreads();
                    { const int fr = lane & 15, fq = lane >> 4, p0 = 16 * wave;
                      float ssr[4] = {0.f, 0.f, 0.f, 0.f};
                      f32x4 acc[4][4];
#pragma unroll
                      for (int gI = 0; gI < 4; ++gI) {
#pragma unroll
                          for (int nt = 0; nt < 4; ++nt) acc[gI][nt] = (f32x4){0.f, 0.f, 0.f, 0.f};
                          const float* wsp = args.in[18] + ((size_t)(l * 4 + gI) * 128 + p0 + fr) * 128 + 8 * fq;
#pragma unroll
                          for (int ks = 0; ks < 4; ++ks) { const f32x4 w0 = *(const f32x4*)(wsp + 32 * ks), w1 = *(const f32x4*)(wsp + 32 * ks + 4);
                              u32x4 aw = {pk2(w0[0], w0[1]), pk2(w0[2], w0[3]), pk2(w1[0], w1[1]), pk2(w1[2], w1[3])}; const bf16x8 af = __builtin_bit_cast(bf16x8, aw);
#pragma unroll
                              for (int nt = 0; nt < 4; ++nt) { const bf16x8 bfr = *(const LAS bf16x8*)(vT + (gI * 64 + 16 * nt + fr) * 136 + 32 * ks + 8 * fq);
                                  acc[gI][nt] = __builtin_amdgcn_mfma_f32_16x16x32_bf16(af, bfr, acc[gI][nt], 0, 0, 0); } }
#pragma unroll
                          for (int r = 0; r < 4; ++r) { const int p = p0 + 4 * fq + r; const float bias = args.in[19][(l * 4 + gI) * 128 + p]; const bf16* up = MIX + (size_t)(ci * 128 + p) * MIXP + OFF_SG + gI * 64;
#pragma unroll
                              for (int nt = 0; nt < 4; ++nt) { const float uu = fgelu(bf1(up[16 * nt + fr])); const float ov = uu * (acc[gI][nt][r] + bias); acc[gI][nt][r] = ov; ssr[r] += ov * ov; } }
                      }
#pragma unroll
                      for (int r = 0; r < 4; ++r) { float s = ssr[r]; s += __shfl_xor(s, 1); s += __shfl_xor(s, 2); s += __shfl_xor(s, 4); s += __shfl_xor(s, 8); ssr[r] = __builtin_amdgcn_rsqf(s * (1.f / 256.f) + EPS); }
#pragma unroll
                      for (int gI = 0; gI < 4; ++gI)
#pragma unroll
                          for (int r = 0; r < 4; ++r) { const int p = p0 + 4 * fq + r; bf16* yp = Abuf + (size_t)(ci * 128 + p) * DM + 512 + gI * 64;
#pragma unroll
                              for (int nt = 0; nt < 4; ++nt) { const int c = 16 * nt + fr; yp[c] = (bf16)(pk2(acc[gI][nt][r] * ssr[r] * g_out[512 + gI * 64 + c], 0.f) & 0xffffu); } }
                    }
                    __syncthreads();
                }
                const int nq = last ? MLAT : MTOT, nsc = last ? MLAT : MTOT;
                const int hh = lane >> 3, j = lane & 7;
                const float* gqh = args.in[15] + l * DQK; const float* gkh = args.in[16] + l * DQK;
                float gq[12], gk[12];
#pragma unroll
                for (int i = 0; i < 8; ++i) { gq[i] = gqh[8 * j + i]; gk[i] = gkh[8 * j + i]; }
#pragma unroll
                for (int i = 0; i < 4; ++i) { gq[8 + i] = gqh[64 + 8 * i + j]; gk[8 + i] = gkh[64 + 8 * i + j]; }
#pragma unroll 4
                for (int row = gw; row < MTOT; row += NGW) {
                    const bool lat = row < MLAT; const int t = row & (SEQ - 1);
                    const bf16* mrow = MIX + (size_t)row * MIXP;
                    float cr = 1.f, sr = 0.f, cc = 1.f, sc = 0.f;
                    if (lat) { const f32x2 a = *(const f32x2*)(rope + 2 * ((t >> 6) * 8 + j)), b2 = *(const f32x2*)(rope + 2 * ((t & 63) * 8 + j)); cr = a.x; sr = a.y; cc = b2.x; sc = b2.y; }
                    float sq = 0.f, skv = 0.f;
                    if (lane < 48) { const u32x4 w = *(const u32x4*)(mrow + 8 * lane);
#pragma unroll
                        for (int e = 0; e < 4; ++e) { const float a = bflo(w[e]), b2 = bfhi(w[e]); sq += a * a + b2 * b2; } }
                    if (lane < 32) { const u32x4 w = *(const u32x4*)(mrow + OFF_KV + 8 * lane);
#pragma unroll
                        for (int e = 0; e < 4; ++e) { const float a = bflo(w[e]), b2 = bfhi(w[e]); skv += a * a + b2 * b2; } }
                    const float rq = __builtin_amdgcn_rsqf(wave_sum(sq) * (1.f / QLORA) + EPS), rkv = __builtin_amdgcn_rsqf(wave_sum(skv) * (1.f / KVLORA) + EPS);
                    if (row < nq) {
                        bf16* qp = QRAW + (size_t)row * 768 + hh * DQK;
                        const u32x4 w = *(const u32x4*)(qp + 8 * j); float z[12];
#pragma unroll
                        for (int e = 0; e < 4; ++e) { z[2 * e] = bflo(w[e]) * rq; z[2 * e + 1] = bfhi(w[e]) * rq; }
#pragma unroll
                        for (int i = 0; i < 4; ++i) z[8 + i] = bf1(qp[64 + 8 * i + j]) * rq;
                        float ss = 0.f;
#pragma unroll
                        for (int i = 0; i < 12; ++i) ss += z[i] * z[i];
                        ss += __shfl_xor(ss, 1); ss += __shfl_xor(ss, 2); ss += __shfl_xor(ss, 4);
                        const float hr = __builtin_amdgcn_rsqf(ss * (1.f / DQK) + EPS);
#pragma unroll
                        for (int i = 0; i < 12; ++i) z[i] *= hr * gq[i] * (att::SCALE * 1.4426950408889634f);
                        const float n0 = z[8] * cr - z[9] * sr, n1 = z[9] * cr + z[8] * sr, n2 = z[10] * cc - z[11] * sc, n3 = z[11] * cc + z[10] * sc;
                        u32x4 o; o.x = pk2(z[0], z[1]); o.y = pk2(z[2], z[3]); o.z = pk2(z[4], z[5]); o.w = pk2(z[6], z[7]);
                        *(u32x4*)(qp + 8 * j) = o;
                        qp[64 + j] = (bf16)(pk2(n0, 0.f) & 0xffffu); qp[72 + j] = (bf16)(pk2(n1, 0.f) & 0xffffu); qp[80 + j] = (bf16)(pk2(n2, 0.f) & 0xffffu); qp[88 + j] = (bf16)(pk2(n3, 0.f) & 0xffffu);
                    }
                    {
                        bf16* kvp = KVRAW + (size_t)row * 1024 + hh * 128;
                        const u32x4 w = *(const u32x4*)(kvp + 8 * j); float z[12];
#pragma unroll
                        for (int e = 0; e < 4; ++e) { z[2 * e] = bflo(w[e]) * rkv; z[2 * e + 1] = bfhi(w[e]) * rkv; }
#pragma unroll
                        for (int i = 0; i < 4; ++i) z[8 + i] = bf1(mrow[OFF_KPE + 8 * i + j]);
                        float ss = 0.f;
#pragma unroll
                        for (int i = 0; i < 12; ++i) ss += z[i] * z[i];
                        ss += __shfl_xor(ss, 1); ss += __shfl_xor(ss, 2); ss += __shfl_xor(ss, 4);
                        const float hr = __builtin_amdgcn_rsqf(ss * (1.f / DQK) + EPS);
#pragma unroll
                        for (int i = 0; i < 12; ++i) z[i] *= hr * gk[i];
                        const float n0 = z[8] * cr - z[9] * sr, n1 = z[9] * cr + z[8] * sr, n2 = z[10] * cc - z[11] * sc, n3 = z[11] * cc + z[10] * sc;
                        const int kb_ = lat ? (row >> 13) : ((row - MLAT) >> 8), ki_ = lat ? t : SEQ + ((row - MLAT) & (NCTX - 1));
                        bf16* kp = Kbuf + ((size_t)(kb_ * NH + hh) * (SEQ + NCTX) + ki_) * DQK;
                        u32x4 o; o.x = pk2(z[0], z[1]); o.y = pk2(z[2], z[3]); o.z = pk2(z[4], z[5]); o.w = pk2(z[6], z[7]);
                        *(u32x4*)(kp + 8 * j) = o;
                        kp[64 + j] = (bf16)(pk2(n0, 0.f) & 0xffffu); kp[72 + j] = (bf16)(pk2(n1, 0.f) & 0xffffu); kp[80 + j] = (bf16)(pk2(n2, 0.f) & 0xffffu); kp[88 + j] = (bf16)(pk2(n3, 0.f) & 0xffffu);
                        const u32x4 wv = *(const u32x4*)(kvp + 64 + 8 * j); u32x4 ov;
#pragma unroll
                        for (int e = 0; e < 4; ++e) ov[e] = pk2(bflo(wv[e]) * rkv, bfhi(wv[e]) * rkv);
                        *(u32x4*)(Vbuf + ((size_t)(kb_ * NH + hh) * (SEQ + NCTX) + ki_) * DV + 8 * j) = ov;
                    }
                    if (row < nsc) {
                        const int tt = lat ? t : (row & (NCTX - 1)); const int tmax = lat ? SEQ - 1 : NCTX - 1;
                        const float* wc = args.in[20] + l * 3 * 256 + 4 * lane;
                        f32x4 y = {0.f, 0.f, 0.f, 0.f};
#pragma unroll
                        for (int d = 0; d < 3; ++d) { const int t2 = tt + d - 1;
                            if (t2 >= 0 && t2 <= tmax) { const bf16* r2 = MIX + (size_t)(row + d - 1) * MIXP + OFF_CONV;
                                const u32x2 cg2 = *(const u32x2*)(r2 + 256 + 4 * lane), xi = *(const u32x2*)(r2 + 512 + 4 * lane); const f32x4 w4 = *(const f32x4*)(wc + d * 256);
                                y.x += w4.x * bflo(cg2.x) * bflo(xi.x); y.y += w4.y * bfhi(cg2.x) * bfhi(xi.x); y.z += w4.z * bflo(cg2.y) * bflo(xi.y); y.w += w4.w * bfhi(cg2.y) * bfhi(xi.y); } }
                        const u32x2 bg = *(const u32x2*)(mrow + OFF_CONV + 4 * lane);
                        y.x *= bflo(bg.x); y.y *= bfhi(bg.x); y.z *= bflo(bg.y); y.w *= bfhi(bg.y);
                        const float rs = __builtin_amdgcn_rsqf(wave_sum((y.x * y.x + y.y * y.y) + (y.z * y.z + y.w * y.w)) * (1.f / 256.f) + EPS);
                        const f32x4 gg = *(const f32x4*)(g_out + 768 + 4 * lane);
                        u32x2 o; o.x = pk2(y.x * rs * gg.x, y.y * rs * gg.y); o.y = pk2(y.z * rs * gg.z, y.w * rs * gg.w);
                        *(u32x2*)(Abuf + (size_t)row * DM + 768 + 4 * lane) = o;
                    }
                }
            } else if (k == 7 && PHEN(7)) {
                const int nlat = NB * NH * 32, nun = last ? nlat : nlat + NB * NH;
                float bl2;
                { const float* gqh = args.in[15] + l * DQK; const float* gkh = args.in[16] + l * DQK;
                  float a = fabsf(gqh[lane]), c = fabsf(gkh[lane]); if (lane < 32) { a = fmaxf(a, fabsf(gqh[64 + lane])); c = fmaxf(c, fabsf(gkh[64 + lane])); }
#pragma unroll
                  for (int o = 1; o < 64; o <<= 1) { a = fmaxf(a, __shfl_xor(a, o)); c = fmaxf(c, __shfl_xor(c, o)); }
                  bl2 = 1.02f * 96.f * a * c * (att::SCALE * 1.4426950408889634f); }
                const bool fastpath = bl2 <= 48.f;
                for (int u = bx; u < nun; u += G) {
                    int b, h, qrow0, tb, nt;
                    if (u < nlat) { const int rr = u / 256, i = u % 256; const int bh = (i & 7) * 4 + rr, qb = i >> 3; b = bh >> 3; h = bh & 7; qrow0 = b * SEQ + qb * 256; tb = 0; nt = 132; }
                    else { const int bh = u - nlat; b = bh >> 3; h = bh & 7; qrow0 = MLAT + b * NCTX; tb = 128; nt = 4; }
                    if (fastpath) att::attn_unit_m16(QRAW + (size_t)qrow0 * 768 + h * DQK, Kbuf + (size_t)(b * NH + h) * (SEQ + NCTX) * DQK, Vbuf + (size_t)(b * NH + h) * (SEQ + NCTX) * DV, Obuf + (size_t)qrow0 * 512 + h * DV, tb, nt, (LAS char*)lds, tid);
                    else att::attn_unit(QRAW + (size_t)qrow0 * 768 + h * DQK, Kbuf + (size_t)(b * NH + h) * (SEQ + NCTX) * DQK, Vbuf + (size_t)(b * NH + h) * (SEQ + NCTX) * DV, Obuf + (size_t)qrow0 * 512 + h * DV, b, tb, nt, (char*)lds_raw, tid);
                }
            } else if (k == 8 && PHEN(8)) {
                const float* g_out = args.in[21] + l * DM; const int nrows = last ? MLAT : MTOT;
#pragma unroll 2
                for (int row = gw; row < nrows; row += NGW) {
                    const u32x4 w = *(const u32x4*)(Obuf + (size_t)row * 512 + 8 * lane); float z[8]; float ss = 0.f;
#pragma unroll
                    for (int e = 0; e < 4; ++e) { z[2 * e] = bflo(w[e]); z[2 * e + 1] = bfhi(w[e]); ss += z[2 * e] * z[2 * e] + z[2 * e + 1] * z[2 * e + 1]; }
                    const float rs = __builtin_amdgcn_rsqf(wave_sum(ss) * (1.f / 512.f) + EPS);
                    const f32x4 g0 = *(const f32x4*)(g_out + 8 * lane), g1 = *(const f32x4*)(g_out + 8 * lane + 4);
                    u32x4 o; o.x = pk2(z[0] * rs * g0.x, z[1] * rs * g0.y); o.y = pk2(z[2] * rs * g0.z, z[3] * rs * g0.w); o.z = pk2(z[4] * rs * g1.x, z[5] * rs * g1.y); o.w = pk2(z[6] * rs * g1.z, z[7] * rs * g1.w);
                    *(u32x4*)(Abuf + (size_t)row * DM + 8 * lane) = o;
                }
            }
        }
#undef args
        if (ph + 1 < ph_hi) { XcdBarrier xb; xb.bar = (unsigned*)(ws + WS_CTL); xb.x = xb_xcc_id(); xb.st = MISC; xcd_barrier(xb); }
    }
}

extern "C" void kernel_launch(void* const* d_in, const int* in_sizes, int n_in, void* d_out, int out_size, void* d_ws, size_t ws_size, hipStream_t stream) {
    static int grid = 0;
    if (grid == 0) {
        if (n_in != 26 || in_sizes[0] != MLAT * DM || out_size != MLAT * DM || ws_size < WS_END) {
            fprintf(stderr, "kernel_launch: unexpected shapes (n_in %d, in0 %d, out %d, ws %zu, need %zu)\n", n_in, n_in > 0 ? in_sizes[0] : -1, out_size, ws_size, (size_t)WS_END); grid = -1; return; }
        int dev = 0, cus = 0, per_cu = 0;
        hipGetDevice(&dev); hipDeviceGetAttribute(&cus, hipDeviceAttributeMultiprocessorCount, dev);
        if (hipFuncSetAttribute((const void*)mk_fwd, hipFuncAttributeMaxDynamicSharedMemorySize, LDS_BYTES) != hipSuccess) { fprintf(stderr, "kernel_launch: hipFuncSetAttribute failed\n"); grid = -1; return; }
        if (hipOccupancyMaxActiveBlocksPerMultiprocessor(&per_cu, (const void*)mk_fwd, 512, LDS_BYTES) != hipSuccess || per_cu < 1) { fprintf(stderr, "kernel_launch: occupancy query gave %d\n", per_cu); per_cu = 1; }
        (void)hipGetLastError();
        grid = cus * per_cu;
        fprintf(stderr, "kernel_launch: grid %d (cus %d x %d)\n", grid, cus, per_cu);
    }
    if (grid < 0) return;
    if (hipMemsetAsync((char*)d_ws + WS_CTL, 0, CTL_BYTES, stream) != hipSuccess) { fprintf(stderr, "kernel_launch: memset failed\n"); return; }
    Args a{};
    for (int i = 0; i < 26; ++i) a.in[i] = (const float*)d_in[i];
    a.out = (float*)d_out; a.ws = (unsigned char*)d_ws;
#if MK_MULTI
    for (int p = 0; p < NPHASES; ++p) { a.ph_lo = p; a.ph_hi = p + 1; hipLaunchKernelGGL(mk_fwd, dim3(grid), dim3(512), LDS_BYTES, stream, a); }
#else
    a.ph_lo = 0; a.ph_hi = NPHASES;
    void* kargs[] = {&a};
    hipError_t e = hipLaunchCooperativeKernel((const void*)mk_fwd, dim3(grid), dim3(512), kargs, LDS_BYTES, stream);
    if (e != hipSuccess) fprintf(stderr, "kernel_launch: cooperative launch failed: %s (grid %d)\n", hipGetErrorString(e), grid);
#endif
}
```

```cpp
#include <hip/hip_runtime.h>
#include <hip/hip_cooperative_groups.h>
#include <cstdio>
#include <cstdint>
namespace cg = cooperative_groups;

#ifndef MK_MULTI
#define MK_MULTI 0
#endif

#ifndef PHMASK
#define PHMASK 0xFFFF
#endif
#define PHEN(n) (((PHMASK) >> (n)) & 1)
#ifndef REPK
#define REPK -1
#endif
#define LAS __attribute__((address_space(3)))
typedef unsigned short bf16;
typedef short bf16x8 __attribute__((ext_vector_type(8)));
typedef short s16x4 __attribute__((ext_vector_type(4)));
typedef float f32x4 __attribute__((ext_vector_type(4)));
typedef float f32x2 __attribute__((ext_vector_type(2)));
typedef float f32x16 __attribute__((ext_vector_type(16)));
typedef unsigned u32x4 __attribute__((ext_vector_type(4)));
typedef unsigned u32x2 __attribute__((ext_vector_type(2)));
typedef __bf16 bf16x2_t __attribute__((ext_vector_type(2)));

constexpr int DM = 1024, NB = 4, SEQ = 8192, NCTX = 256, DFF = 2816;
constexpr int MLAT = NB * SEQ, MCTX = NB * NCTX, MTOT = MLAT + MCTX;
constexpr int NH = 8, DQK = 96, DV = 64, QLORA = 384, KVLORA = 256;
constexpr int OFF_KV = 384, OFF_KPE = 640, OFF_SG = 672, OFF_CONV = 1184, MIXN = 1952, MIXP = 2048;
constexpr int ADA = 9 * DM;
constexpr float EPS = 1e-6f;

constexpr size_t MiB = 1u << 20;
constexpr size_t WS_MOD = 0, WS_ROPE = 1 * MiB, WS_CTL = 1 * MiB + 512 * 1024, CTL_BYTES = 16384, WS_W = 2 * MiB, W_LAYER = 41 * MiB;
constexpr size_t WO_FFN1IN = 0, WO_FFN1OUT = 11 * MiB, WO_MIXIN = WO_FFN1OUT + 5767168, WO_QUP = WO_MIXIN + 4 * MiB, WO_KVUP = WO_QUP + 589824,
                 WO_MIXOUT = WO_KVUP + 524288, WO_FFN2IN = WO_MIXOUT + 2 * MiB, WO_FFN2OUT = WO_FFN2IN + 11 * MiB;
static_assert(WO_FFN2OUT + 5767168 <= W_LAYER, "weights");
constexpr size_t WS_HC = 84 * MiB, WS_A = 88 * MiB, WS_R = 154 * MiB;
constexpr size_t R_U = 0, R_MIX = 0, R_O = 0  , R_V = 132 * MiB  , R_QRAW = 165 * MiB, R_KVRAW = R_QRAW + (size_t)MTOT * 768 * 2, R_K = R_KVRAW + 66 * MiB;
constexpr size_t WS_END = WS_R + R_K + (size_t)MTOT * 768 * 2;
static_assert(WS_END <= 512 * MiB, "ws");
static_assert((size_t)MTOT * DFF * 2 <= 330 * MiB, "U");

__device__ __forceinline__ unsigned pk2(float lo, float hi) { f32x2 v = {lo, hi}; bf16x2_t b = __builtin_convertvector(v, bf16x2_t); return __builtin_bit_cast(unsigned, b); }
__device__ __forceinline__ float bflo(unsigned w) { return __uint_as_float(w << 16); }
__device__ __forceinline__ float bfhi(unsigned w) { return __uint_as_float(w & 0xffff0000u); }
__device__ __forceinline__ float bf1(bf16 h) { return __uint_as_float((unsigned)h << 16); }
__device__ __forceinline__ float wave_sum(float v) {
#pragma unroll
    for (int o = 1; o < 64; o <<= 1) v += __shfl_xor(v, o);
    return v;
}
__device__ __forceinline__ float fsilu(float x) { return x * __builtin_amdgcn_rcpf(1.f + __builtin_amdgcn_exp2f(-1.4426950408889634f * x)); }
__device__ __forceinline__ float fgelu(float x) {
    const float z = 1.5957691216057308f * (x + 0.044715f * x * x * x);
    return x * __builtin_amdgcn_rcpf(1.f + __builtin_amdgcn_exp2f(-1.4426950408889634f * z));
}

namespace pg8 {
constexpr int BM = 256, BK = 64, HALF = 128, HTB = HALF * BK * 2, STAGE_BYTES = 8 * HTB, NXCD = 8, WGM = 8;
__host__ __device__ __forceinline__ int lds_byte(int r, int c) { const int st = (r >> 4) * 2 + (c >> 5), rr = r & 15, cc = c & 31, ob = rr * 64 + cc * 2; return st * 1024 + (ob ^ (((ob >> 9) & 1) << 5)); }
__host__ __device__ __forceinline__ void stage_rc(int b, int& R, int& C) { const int st = b / 1024, sb = b % 1024, swz = sb ^ (((sb >> 9) & 1) << 5); R = (st >> 1) * 16 + swz / 64; C = (st & 1) * 32 + (swz % 64) / 2; }
__host__ __device__ __forceinline__ int perm32(int rho) { const int n = rho >> 4, i = rho & 15; return 8 * (i >> 2) + 4 * n + (i & 3); }
struct Unit { int pm, pn, k0, nt; };
struct Gemm { const bf16* A; const bf16* Bt; int M, N, K, lda; };
struct StaticOrder {
    int nM, nN, nwg, G, c, ntfull, nsplit, ntsub, ntail;
    __device__ void init(int M, int N, int K, int G_, int c_, int Msplit = 0, int ntsub_ = 0) {
        nM = (M - Msplit) / BM; nN = N / BM; nwg = nM * nN; G = G_; c = c_; ntfull = K / BK;
        ntsub = ntsub_ > 0 ? ntsub_ : ntfull; nsplit = ntfull / ntsub; ntail = (Msplit / BM) * nN * nsplit; }
    __device__ bool next(int i, Unit& u) const {
        const long L = (long)i * G + c; if (L >= nwg + ntail) return false;
        if (L >= nwg) { const int s = (int)L - nwg, nt4 = (ntail / nsplit), tile = s % nt4, ks = s / nt4; u.pm = nM + tile / nN; u.pn = tile % nN; u.k0 = ks * ntsub; u.nt = ntsub; return true; }
        int wgid = (int)L; { const int q = nwg / NXCD, r = nwg % NXCD, xcd = wgid % NXCD, off = wgid / NXCD; wgid = (xcd < r ? xcd * (q + 1) : r * (q + 1) + (xcd - r) * q) + off; }
        const int nig = WGM * nN, gid = wgid / nig, fm = gid * WGM, gsz = (nM - fm) < WGM ? (nM - fm) : WGM;
        u.pm = fm + ((wgid % nig) % gsz); u.pn = (wgid % nig) / gsz; u.k0 = 0; u.nt = ntfull; return true;
    }
};
struct EpiStore {
    static constexpr bool PERM = true;
    bf16* O; int ldc;
    __device__ __forceinline__ void operator()(const f32x4 (&acc)[2][2][4][2], const Unit& u, int wr, int wc, int fr, int fq) const {
        const int row0 = u.pm * BM + wr * 64 + fr, col0 = u.pn * BM + wc * 32 + 8 * fq;
#pragma unroll
        for (int ai = 0; ai < 2; ++ai)
#pragma unroll
            for (int m = 0; m < 4; ++m) { bf16* rowp = O + (size_t)(row0 + ai * HALF + m * 16) * ldc + col0;
#pragma unroll
                for (int bj = 0; bj < 2; ++bj) { const f32x4 v0 = acc[ai][bj][m][0], v1 = acc[ai][bj][m][1];
                    u32x4 w; w.x = pk2(v0[0], v0[1]); w.y = pk2(v0[2], v0[3]); w.z = pk2(v1[0], v1[1]); w.w = pk2(v1[2], v1[3]);
                    *(u32x4*)(rowp + bj * HALF) = w; } }
    }
};
struct EpiSwiGLU {
    static constexpr bool PERM = true;
    bf16* U; int ldu;
    __device__ __forceinline__ void operator()(const f32x4 (&acc)[2][2][4][2], const Unit& u, int wr, int wc, int fr, int fq) const {
        const int row0 = u.pm * BM + wr * 64 + fr, col0 = u.pn * HALF + wc * 32 + 8 * fq;
#pragma unroll
        for (int ai = 0; ai < 2; ++ai)
#pragma unroll
            for (int m = 0; m < 4; ++m) { bf16* rowp = U + (size_t)(row0 + ai * HALF + m * 16) * ldu + col0;
                const f32x4 a0 = acc[ai][0][m][0], a1 = acc[ai][0][m][1], b0 = acc[ai][1][m][0], b1 = acc[ai][1][m][1];
                u32x4 w; w.x = pk2(fsilu(a0[0]) * b0[0], fsilu(a0[1]) * b0[1]); w.y = pk2(fsilu(a0[2]) * b0[2], fsilu(a0[3]) * b0[3]);
                w.z = pk2(fsilu(a1[0]) * b1[0], fsilu(a1[1]) * b1[1]); w.w = pk2(fsilu(a1[2]) * b1[2], fsilu(a1[3]) * b1[3]);
                *(u32x4*)rowp = w; }
    }
};
struct EpiResid {
    static constexpr bool PERM = true;
    const float* rin_lat; const float* rin_ctx; float* out_lat; float* out_ctx; const float* gate; float coef; int ntfull; float* part;
    __device__ __forceinline__ void operator()(const f32x4 (&acc)[2][2][4][2], const Unit& u, int wr, int wc, int fr, int fq) const {
        asm volatile("" : "+v"(fr), "+v"(fq));
        const bool lat = u.pm < MLAT / BM; const int s = lat ? (u.pm >> 5) : 4;
        const size_t tbase = lat ? (size_t)u.pm * BM * DM : (size_t)(u.pm - MLAT / BM) * BM * DM;
        const long long di = lat ? 0ll : (long long)((const char*)rin_ctx - (const char*)rin_lat), dq = lat ? 0ll : (long long)((char*)out_ctx - (char*)out_lat);
        const float* rin = (const float*)((const char*)rin_lat + di) + tbase; float* out = (float*)((char*)out_lat + dq) + tbase;
        const int col0 = u.pn * BM + wc * 32 + 8 * fq;
        if (u.nt != ntfull) {
            float* pp = part + (size_t)(u.k0 / u.nt) * ((size_t)MCTX * DM) + tbase;
#pragma unroll
            for (int bj = 0; bj < 2; ++bj) { const int col = col0 + bj * HALF; const f32x4 g0 = *(const f32x4*)(gate + (size_t)s * ADA + col) * coef, g1 = *(const f32x4*)(gate + (size_t)s * ADA + col + 4) * coef;
#pragma unroll
                for (int ai = 0; ai < 2; ++ai)
#pragma unroll
                    for (int m = 0; m < 4; ++m) { const size_t off = (size_t)(ai * HALF + wr * 64 + m * 16 + fr) * DM + col; *(f32x4*)(pp + off) = g0 * acc[ai][bj][m][0]; *(f32x4*)(pp + off + 4) = g1 * acc[ai][bj][m][1]; } }
            return;
        }
#pragma unroll
        for (int bj = 0; bj < 2; ++bj) { const int col = col0 + bj * HALF; const f32x4 g0 = *(const f32x4*)(gate + (size_t)s * ADA + col) * coef, g1 = *(const f32x4*)(gate + (size_t)s * ADA + col + 4) * coef;
#pragma unroll
            for (int ai = 0; ai < 2; ++ai) { f32x4 r[4][2];
#pragma unroll
                for (int m = 0; m < 4; ++m) { const size_t off = (size_t)(ai * HALF + wr * 64 + m * 16 + fr) * DM + col; r[m][0] = *(const f32x4*)(rin + off); r[m][1] = *(const f32x4*)(rin + off + 4); }
                asm volatile("" ::: "memory");
#pragma unroll
                for (int m = 0; m < 4; ++m) { const size_t off = (size_t)(ai * HALF + wr * 64 + m * 16 + fr) * DM + col;
                    *(f32x4*)(out + off) = r[m][0] + g0 * acc[ai][bj][m][0]; *(f32x4*)(out + off + 4) = r[m][1] + g1 * acc[ai][bj][m][1]; }
                asm volatile("" ::: "memory"); } }
    }
};

template <class Epi>
__device__ __forceinline__ void gemm_phase(LAS unsigned char* lds, const Gemm g, const StaticOrder& S, const Epi& E, const int tid) {
    const int wid = __builtin_amdgcn_readfirstlane(tid >> 6), lane = tid & 63, wr = wid >> 2, wc = wid & 3, fr = lane & 15, fq = lane >> 4;
    const int K = g.K, lda = g.lda;
    unsigned voffA[2], voffB[2];
#pragma unroll
    for (int i = 0; i < 2; ++i) { int R, C; stage_rc(tid * 16 + i * 8192, R, C); const int Rb = Epi::PERM ? ((R & ~31) + perm32(R & 31)) : R;
        voffA[i] = (unsigned)(R * lda + C) * 2u; voffB[i] = (unsigned)(Rb * K + C) * 2u; }
    const size_t kstep = (size_t)(BK * 2);
    const size_t hstepA = (size_t)HALF * lda * 2, hstepB = (size_t)HALF * K * 2;
    const size_t tstepA = 2 * hstepA, tstepB = 2 * hstepB;
    const unsigned ldsw = (unsigned)wid * 1024u;
    const int aoff = lds_byte(wr * 64 + fr, fq * 8), boff = lds_byte(wc * 32 + fr, fq * 8);
#define PG8_SA(b, h) (((b) * 2 + (h)) * HTB)
#define PG8_SB(b, h) ((4 + (b) * 2 + (h)) * HTB)
#define PG8_STAGE(bufoff, gbase, voff) do { _Pragma("unroll") for (int _i = 0; _i < 2; ++_i) \
        __builtin_amdgcn_global_load_lds((const unsigned*)((const char*)(gbase) + (voff)[_i]), (LAS unsigned*)(lds + (bufoff) + ldsw + _i * 8192), 16, 0, 0); } while (0)
#define PG8_LDA(dst, b, h) do { _Pragma("unroll") for (int m = 0; m < 4; ++m) _Pragma("unroll") for (int k = 0; k < 2; ++k) dst[m][k] = *(const LAS bf16x8*)(lds + PG8_SA(b, h) + aoff + m * 2048 + k * 1024); } while (0)
#define PG8_LDB(dst, b, h) do { _Pragma("unroll") for (int n = 0; n < 2; ++n) _Pragma("unroll") for (int k = 0; k < 2; ++k) dst[n][k] = *(const LAS bf16x8*)(lds + PG8_SB(b, h) + boff + n * 2048 + k * 1024); } while (0)
#define PG8_MMA(ai, bj, At, Bt) do { __builtin_amdgcn_s_setprio(1); _Pragma("unroll") for (int m = 0; m < 4; ++m) _Pragma("unroll") for (int n = 0; n < 2; ++n) _Pragma("unroll") for (int k = 0; k < 2; ++k) \
        acc[ai][bj][m][n] = __builtin_amdgcn_mfma_f32_16x16x32_bf16(Bt[n][k], At[m][k], acc[ai][bj][m][n], 0, 0, 0); __builtin_amdgcn_s_setprio(0); } while (0)
#define PG8_WAIT_V(n) asm volatile("s_waitcnt vmcnt(" #n ")" ::: "memory")
#define PG8_WAIT_L(n) asm volatile("s_waitcnt lgkmcnt(" #n ")" ::: "memory")
#define PG8_BAR __builtin_amdgcn_s_barrier()
#define PG8_SCHED __builtin_amdgcn_sched_barrier(0)
    Unit cur, nxt; int ui = 0;
    if (!S.next(0, cur)) return;
    f32x4 acc[2][2][4][2];
#pragma unroll
    for (int a = 0; a < 2; ++a)
#pragma unroll
        for (int b = 0; b < 2; ++b)
#pragma unroll
            for (int m = 0; m < 4; ++m)
#pragma unroll
                for (int n = 0; n < 2; ++n) acc[a][b][m][n] = (f32x4){0.f, 0.f, 0.f, 0.f};
    bf16x8 At[4][2], B0[2][2], B1[2][2];
    const char* cA = (const char*)g.A + (size_t)cur.pm * tstepA + (size_t)cur.k0 * kstep; const char* cB = (const char*)g.Bt + (size_t)cur.pn * tstepB + (size_t)cur.k0 * kstep;
    PG8_STAGE(PG8_SB(0, 0), cB, voffB); PG8_STAGE(PG8_SB(0, 1), cB + hstepB, voffB); PG8_STAGE(PG8_SA(0, 0), cA, voffA); PG8_STAGE(PG8_SA(0, 1), cA + hstepA, voffA);
    if (wr == 1) PG8_BAR;
    PG8_WAIT_V(2); PG8_BAR;
    PG8_STAGE(PG8_SB(1, 0), cB + kstep, voffB); PG8_STAGE(PG8_SA(1, 0), cA + kstep, voffA); PG8_STAGE(PG8_SB(1, 1), cB + hstepB + kstep, voffB);
    PG8_WAIT_V(6); PG8_BAR;
    for (;;) {
        const bool has_next = S.next(ui + 1, nxt);
        const char* nA = has_next ? (const char*)g.A + (size_t)nxt.pm * tstepA + (size_t)nxt.k0 * kstep : cA; const char* nB = has_next ? (const char*)g.Bt + (size_t)nxt.pn * tstepB + (size_t)nxt.k0 * kstep : cB;
        const int nt = cur.nt;
        for (int t = 0; t < nt; t += 2) {
            const bool last = (t == nt - 2);
            const char* a1 = cA + (size_t)(t + 1) * kstep;
            const char* a2 = last ? nA : cA + (size_t)(t + 2) * kstep; const char* b2 = last ? nB : cB + (size_t)(t + 2) * kstep;
            const char* a3 = a2 + kstep; const char* b3 = b2 + kstep;
            PG8_LDB(B0, 0, 0); PG8_LDB(B1, 0, 1); PG8_SCHED; PG8_LDA(At, 0, 0); PG8_STAGE(PG8_SA(1, 1), a1 + hstepA, voffA);
            PG8_WAIT_V(8); PG8_WAIT_L(0); PG8_BAR; PG8_MMA(0, 0, At, B0); PG8_MMA(0, 1, At, B1); PG8_BAR; PG8_SCHED;
            PG8_LDA(At, 0, 1); PG8_STAGE(PG8_SB(0, 0), b2, voffB); PG8_STAGE(PG8_SB(0, 1), b2 + hstepB, voffB); PG8_STAGE(PG8_SA(0, 0), a2, voffA);
            PG8_WAIT_V(8); PG8_WAIT_L(0); PG8_BAR; PG8_MMA(1, 0, At, B0); PG8_MMA(1, 1, At, B1); PG8_BAR; PG8_SCHED;
            PG8_LDB(B0, 1, 0); PG8_LDB(B1, 1, 1); PG8_SCHED; PG8_LDA(At, 1, 0); PG8_STAGE(PG8_SA(0, 1), a2 + hstepA, voffA);
            PG8_WAIT_V(8); PG8_WAIT_L(0); PG8_BAR; PG8_MMA(0, 0, At, B0); PG8_MMA(0, 1, At, B1); PG8_BAR; PG8_SCHED;
            PG8_LDA(At, 1, 1); PG8_STAGE(PG8_SB(1, 0), b3, voffB); PG8_STAGE(PG8_SB(1, 1), b3 + hstepB, voffB); PG8_STAGE(PG8_SA(1, 0), a3, voffA);
            PG8_WAIT_V(8); PG8_WAIT_L(0); PG8_BAR; PG8_MMA(1, 0, At, B0); PG8_MMA(1, 1, At, B1); PG8_BAR; PG8_SCHED;
        }
        if (wr == 0) PG8_BAR;
        E(acc, cur, wr, wc, fr, fq);
        if (!has_next) break;
#pragma unroll
        for (int a = 0; a < 2; ++a)
#pragma unroll
            for (int b = 0; b < 2; ++b)
#pragma unroll
                for (int m = 0; m < 4; ++m)
#pragma unroll
                    for (int n = 0; n < 2; ++n) acc[a][b][m][n] = (f32x4){0.f, 0.f, 0.f, 0.f};
        cur = nxt; cA = nA; cB = nB; ++ui;
        if (wr == 1) PG8_BAR;
    }
    PG8_WAIT_V(0);
    PG8_BAR;
#undef PG8_SA
#undef PG8_SB
#undef PG8_STAGE
#undef PG8_LDA
#undef PG8_LDB
#undef PG8_MMA
#undef PG8_WAIT_V
#undef PG8_WAIT_L
#undef PG8_BAR
#undef PG8_SCHED
}
}

namespace att {
constexpr int NW = 8, QBLK = 32, KVBLK = 64;
constexpr float SCALE = 0.10206207261596575f;
constexpr float THR = 8.f;
constexpr int SHM_V = KVBLK * DV * 2, SHM_K = KVBLK * 256;
constexpr int LDS_V = 0, LDS_K = 2 * SHM_V, LDS_WS = LDS_K + 2 * SHM_K, LDS_BYTES = LDS_WS + NW * 64 * 4;
#define KSWZ(row, colB) ((row) * 256 + ((colB) ^ (((row) & 7) << 4)))
#define SBAR() __builtin_amdgcn_sched_barrier(0)
__device__ __forceinline__ int crow(int r, int hi) { return (r & 3) + 8 * (r >> 2) + 4 * hi; }
__device__ __forceinline__ unsigned cvtpk(float lo, float hi) { unsigned r; asm volatile("v_cvt_pk_bf16_f32 %0, %1, %2" : "=v"(r) : "v"(lo), "v"(hi)); return r; }
__device__ __forceinline__ void partialSM(f32x16& p0, f32x16& p1, float& m_reg, float& mn, float& alpha) {
    constexpr float C = 1.0f;
    float pmax = p0[0];
#pragma unroll
    for (int r = 1; r < 16; ++r) pmax = fmaxf(pmax, p0[r]);
#pragma unroll
    for (int r = 0; r < 16; ++r) pmax = fmaxf(pmax, p1[r]);
    { auto rr = __builtin_amdgcn_permlane32_swap(__float_as_uint(pmax), __float_as_uint(pmax), false, false);
      pmax = fmaxf(__uint_as_float(rr[0]), __uint_as_float(rr[1])); }
    if (__builtin_expect(__all(pmax - m_reg <= THR * 1.4426950408889634f), 1)) { mn = m_reg; alpha = 1.f; }
    else { mn = fmaxf(m_reg, pmax); alpha = __builtin_amdgcn_exp2f((m_reg - mn) * C); m_reg = mn; }
    const float mnC = -mn * C;
#pragma unroll
    for (int r = 0; r < 16; ++r) p0[r] = fmaf(p0[r], C, mnC);
#pragma unroll
    for (int r = 0; r < 16; ++r) p1[r] = fmaf(p1[r], C, mnC);
#pragma unroll
    for (int r = 0; r < 16; ++r) p0[r] = __builtin_amdgcn_exp2f(p0[r]);
}
__device__ __forceinline__ void finishSM(f32x16& p0, f32x16& p1, float alpha, float& l_reg, bf16x8& pa0, bf16x8& pa1, bf16x8& pa2, bf16x8& pa3) {
#pragma unroll
    for (int r = 0; r < 16; ++r) p1[r] = __builtin_amdgcn_exp2f(p1[r]);
    float ps = 0;
#pragma unroll
    for (int r = 0; r < 16; ++r) ps += p0[r];
#pragma unroll
    for (int r = 0; r < 16; ++r) ps += p1[r];
    { auto rr = __builtin_amdgcn_permlane32_swap(__float_as_uint(ps), __float_as_uint(ps), false, false);
      ps = __uint_as_float(rr[0]) + __uint_as_float(rr[1]); }
    l_reg = l_reg * alpha + ps;
#define PK4(P, BASE, OUT) do { unsigned a0 = cvtpk(P[BASE + 0], P[BASE + 1]), a1 = cvtpk(P[BASE + 2], P[BASE + 3]);   \
    unsigned b0 = cvtpk(P[BASE + 4], P[BASE + 5]), b1 = cvtpk(P[BASE + 6], P[BASE + 7]);                              \
    auto r0 = __builtin_amdgcn_permlane32_swap(a0, b0, false, false); auto r1 = __builtin_amdgcn_permlane32_swap(a1, b1, false, false); \
    u32x4 w = {r0[0], r1[0], r0[1], r1[1]}; OUT = __builtin_bit_cast(bf16x8, w); } while (0)
    PK4(p0, 0, pa0); PK4(p0, 8, pa1); PK4(p1, 0, pa2); PK4(p1, 8, pa3);
#undef PK4
}
__device__ __forceinline__ void qkt(f32x16& p0, f32x16& p1, const char* Ks, const bf16x8* qr, int r32, int hi) {
    p0 = f32x16{}; p1 = f32x16{};
#pragma unroll
    for (int d0 = 0; d0 < 6; ++d0) { const int cb = (d0 * 16 + hi * 8) * 2;
        const bf16x8 b0 = *reinterpret_cast<const bf16x8*>(Ks + KSWZ(r32, cb));
        const bf16x8 b1 = *reinterpret_cast<const bf16x8*>(Ks + KSWZ(32 + r32, cb));
        p0 = __builtin_amdgcn_mfma_f32_32x32x16_bf16(b0, qr[d0], p0, 0, 0, 0);
        p1 = __builtin_amdgcn_mfma_f32_32x32x16_bf16(b1, qr[d0], p1, 0, 0, 0); }
}
__device__ __forceinline__ int v_st(int k, int c) { const int kk = (k & ~0xC) | ((k & 4) << 1) | ((k & 8) >> 1); return ((kk >> 3) * 2 + (c >> 5)) * 512 + ((kk & 7) * 32 + (c & 31)) * 2; }
__device__ __forceinline__ int v_rd_base(int lane) { return ((lane & 3) << 3) | (((lane >> 2) & 3) << 6) | (((lane >> 4) & 1) << 5) | (((lane >> 5) & 1) << 8); }
constexpr int v_rd_off(int d0, int ks, int half) { return d0 * 512 + ks * 2048 + half * 1024; }
template <int OFF> __device__ __forceinline__ s16x4 tr_read(int vb) { s16x4 r; asm volatile("ds_read_b64_tr_b16 %0, %1 offset:%2" : "=&v"(r) : "v"(vb), "i"(OFF) : "memory"); return r; }
template <int D0> __device__ __forceinline__ void pv_one(f32x16& od, int vb, bf16x8 pa0, bf16x8 pa1, bf16x8 pa2, bf16x8 pa3) {
    const s16x4 l0 = tr_read<v_rd_off(D0, 0, 0)>(vb), h0 = tr_read<v_rd_off(D0, 0, 1)>(vb), l1 = tr_read<v_rd_off(D0, 1, 0)>(vb), h1 = tr_read<v_rd_off(D0, 1, 1)>(vb);
    const s16x4 l2 = tr_read<v_rd_off(D0, 2, 0)>(vb), h2 = tr_read<v_rd_off(D0, 2, 1)>(vb), l3 = tr_read<v_rd_off(D0, 3, 0)>(vb), h3 = tr_read<v_rd_off(D0, 3, 1)>(vb);
    asm volatile("s_waitcnt lgkmcnt(0)" ::: "memory"); SBAR();
#define PK(L, H) (bf16x8){L[0], L[1], L[2], L[3], H[0], H[1], H[2], H[3]}
    od = __builtin_amdgcn_mfma_f32_32x32x16_bf16(pa0, PK(l0, h0), od, 0, 0, 0);
    od = __builtin_amdgcn_mfma_f32_32x32x16_bf16(pa1, PK(l1, h1), od, 0, 0, 0);
    od = __builtin_amdgcn_mfma_f32_32x32x16_bf16(pa2, PK(l2, h2), od, 0, 0, 0);
    od = __builtin_amdgcn_mfma_f32_32x32x16_bf16(pa3, PK(l3, h3), od, 0, 0, 0);
#undef PK
}
__device__ __forceinline__ void pv_d0(f32x16* o, int vb, bf16x8 pa0, bf16x8 pa1, bf16x8 pa2, bf16x8 pa3) {
    pv_one<0>(o[0], vb, pa0, pa1, pa2, pa3); pv_one<1>(o[1], vb, pa0, pa1, pa2, pa3);
}
__device__ __forceinline__ int krow(int b, int T) { return T < 128 ? b * SEQ + 64 * T : MLAT + NCTX * b + 64 * (T - 128); }
__device__ __forceinline__ void attn_unit(const bf16* __restrict__ Qb, const bf16* __restrict__ Kh, const bf16* __restrict__ Vh, bf16* __restrict__ Ob, int b, int t_begin, int NT, char* lds, const int tid) {
    const int wid = tid >> 6, lane = tid & 63, r32 = lane & 31, hi = lane >> 5;
    char* V_lds = lds + LDS_V; char* K_lds = lds + LDS_K;
    float* ws = (float*)(lds + LDS_WS) + wid * 64; float* li_l = ws; float* al_l = ws + 32;
    float m_reg = -1e30f, l_reg = 0; f32x16 o[2] = {}; bf16x8 qr[6];
    const bf16* Qw = Qb + (long)(wid * QBLK + r32) * 768 + hi * 8;
#pragma unroll
    for (int d0 = 0; d0 < 6; ++d0) qr[d0] = *reinterpret_cast<const bf16x8*>(Qw + d0 * 16);
    const bool kst = wid < 6;
    const int sr = tid / 12, scK = (tid % 12) * 8, vr = tid >> 3, scV = (tid & 7) * 8;
    const int kw0 = KSWZ(sr, scK * 2), kw1 = KSWZ(32 + sr, scK * 2), vw = v_st(vr, scV);
    const int vb0 = (int)(uintptr_t)V_lds + v_rd_base(lane);
    struct { bf16x8 vs0, ks0, ks1; } sr_[2];
#define SLOAD(i, t) do { sr_[i].vs0 = *reinterpret_cast<const bf16x8*>(&Vh[((long)(t_begin + (t)) * 64 + vr) * 64 + scV]); \
    if (kst) { const long kt_ = (long)(t_begin + (t)) * 64; sr_[i].ks0 = *reinterpret_cast<const bf16x8*>(&Kh[(kt_ + sr) * 96 + scK]); sr_[i].ks1 = *reinterpret_cast<const bf16x8*>(&Kh[(kt_ + 32 + sr) * 96 + scK]); } } while (0)
#define SWRITE(bb, i) do { *(bf16x8*)(V_lds + (bb) * SHM_V + vw) = sr_[i].vs0; \
    if (kst) { *(bf16x8*)(K_lds + (bb) * SHM_K + kw0) = sr_[i].ks0; *(bf16x8*)(K_lds + (bb) * SHM_K + kw1) = sr_[i].ks1; } } while (0)
#define RESC(a) do { if (__any((a) < 1.f)) { if (hi == 0) al_l[r32] = (a); asm volatile("s_waitcnt lgkmcnt(0)" ::: "memory"); \
    _Pragma("unroll") for (int d = 0; d < 2; ++d) _Pragma("unroll") for (int r = 0; r < 16; ++r) o[d][r] *= al_l[crow(r, hi)]; } } while (0)
    f32x16 pA0, pA1, pB0, pB1; float mnA, mnB, alA, alB; bf16x8 pa0, pa1, pa2, pa3;
    constexpr int SE = 0, SO = 1;
    SLOAD(SE, 0); SWRITE(0, SE); __syncthreads();
    qkt(pA0, pA1, K_lds, qr, r32, hi); partialSM(pA0, pA1, m_reg, mnA, alA);
    SLOAD(SO, 1); if (2 < NT) SLOAD(SE, 2);
    SWRITE(1, SO); __syncthreads();
    for (int j = 1; j + 1 < NT; j += 2) {
        SBAR(); qkt(pB0, pB1, K_lds + SHM_K, qr, r32, hi);
        finishSM(pA0, pA1, alA, l_reg, pa0, pa1, pa2, pa3); SBAR();
        SLOAD(SO, j + 2); SBAR();
        pv_d0(o, vb0, pa0, pa1, pa2, pa3); partialSM(pB0, pB1, m_reg, mnB, alB);
        __syncthreads(); SWRITE(0, SE);
        RESC(alB); __syncthreads();
        SBAR(); qkt(pA0, pA1, K_lds, qr, r32, hi);
        finishSM(pB0, pB1, alB, l_reg, pa0, pa1, pa2, pa3); SBAR();
        if (j + 3 < NT) SLOAD(SE, j + 3); SBAR();
        pv_d0(o, vb0 + SHM_V, pa0, pa1, pa2, pa3); partialSM(pA0, pA1, m_reg, mnA, alA);
        __syncthreads(); SWRITE(1, SO);
        RESC(alA); __syncthreads();
    }
    SBAR(); qkt(pB0, pB1, K_lds + SHM_K, qr, r32, hi);
    finishSM(pA0, pA1, alA, l_reg, pa0, pa1, pa2, pa3); SBAR();
    pv_d0(o, vb0, pa0, pa1, pa2, pa3); partialSM(pB0, pB1, m_reg, mnB, alB);
    __syncthreads(); RESC(alB);
    finishSM(pB0, pB1, alB, l_reg, pa0, pa1, pa2, pa3); SBAR();
    pv_d0(o, vb0 + SHM_V, pa0, pa1, pa2, pa3);
    if (hi == 0) li_l[r32] = l_reg; asm volatile("s_waitcnt lgkmcnt(0)" ::: "memory");
    float rli[16];
#pragma unroll
    for (int r = 0; r < 16; ++r) rli[r] = __builtin_amdgcn_rcpf(li_l[crow(r, hi)]);
    bf16* Ow = Ob + (long)(wid * QBLK) * 512;
#pragma unroll
    for (int r = 0; r < 16; ++r) { const int orow = crow(r, hi);
#pragma unroll
        for (int d0 = 0; d0 < 2; ++d0) Ow[(long)orow * 512 + d0 * 32 + r32] = (bf16)(pk2(o[d0][r] * rli[r], 0.f) & 0xffffu); }
    __syncthreads();
#undef SLOAD
#undef SWRITE
#undef RESC
}

__device__ __forceinline__ s16x4 vtr(const LAS char* p) { typedef short v4i16_t __attribute__((ext_vector_type(4))); return __builtin_bit_cast(s16x4, __builtin_amdgcn_ds_read_tr16_b64_v4i16((LAS v4i16_t*)p)); }
__device__ __forceinline__ void qkt_fs(f32x16& p0, f32x16& p1, const LAS char* Ks, const bf16x8* qr, const f32x16& negb, int r32, int hi) {
#pragma unroll
    for (int d0 = 0; d0 < 6; ++d0) { const int cb = (d0 * 16 + hi * 8) * 2;
        const bf16x8 b0 = *(const LAS bf16x8*)(Ks + KSWZ(r32, cb));
        const bf16x8 b1 = *(const LAS bf16x8*)(Ks + KSWZ(32 + r32, cb));
        p0 = __builtin_amdgcn_mfma_f32_32x32x16_bf16(b0, qr[d0], d0 == 0 ? f32x16{} : p0, 0, 0, 0);
        p1 = __builtin_amdgcn_mfma_f32_32x32x16_bf16(b1, qr[d0], d0 == 0 ? f32x16{} : p1, 0, 0, 0); }
}
__device__ __forceinline__ void expack(f32x16& p0, f32x16& p1, bf16x8& pa0, bf16x8& pa1, bf16x8& pa2, bf16x8& pa3, float& l_reg) {
#pragma unroll
    for (int r = 0; r < 16; ++r) p0[r] = __builtin_amdgcn_exp2f(p0[r]);
#pragma unroll
    for (int r = 0; r < 16; ++r) p1[r] = __builtin_amdgcn_exp2f(p1[r]);
    { f32x2 s0 = {0.f, 0.f}, s1 = {0.f, 0.f};
#pragma unroll
      for (int r = 0; r < 16; r += 2) { s0 += (f32x2){p0[r], p0[r + 1]}; s1 += (f32x2){p1[r], p1[r + 1]}; }
      s0 += s1; l_reg += s0.x + s0.y; }
#define PK4(P, BASE, OUT) do { u32x4 w = {pk2(P[BASE + 0], P[BASE + 1]), pk2(P[BASE + 2], P[BASE + 3]), pk2(P[BASE + 4], P[BASE + 5]), pk2(P[BASE + 6], P[BASE + 7])}; OUT = __builtin_bit_cast(bf16x8, w); } while (0)
    PK4(p0, 0, pa0); PK4(p0, 8, pa1); PK4(p1, 0, pa2); PK4(p1, 8, pa3);
#undef PK4
}
__device__ __forceinline__ void pv3(f32x16* o, const LAS char* vp, bf16x8 pa0, bf16x8 pa1, bf16x8 pa2, bf16x8 pa3) {
#define PK(L, H) (bf16x8){L[0], L[1], L[2], L[3], H[0], H[1], H[2], H[3]}
#define PVK(ks, pa) do { const s16x4 l0 = vtr(vp + (ks) * 2048), h0 = vtr(vp + (ks) * 2048 + 256), l1 = vtr(vp + (ks) * 2048 + 512), h1 = vtr(vp + (ks) * 2048 + 512 + 256); \
    o[0] = __builtin_amdgcn_mfma_f32_32x32x16_bf16(pa, PK(l0, h0), o[0], 0, 0, 0); o[1] = __builtin_amdgcn_mfma_f32_32x32x16_bf16(pa, PK(l1, h1), o[1], 0, 0, 0); } while (0)
    PVK(0, pa0); PVK(1, pa1); PVK(2, pa2); PVK(3, pa3);
#undef PVK
#undef PK
}
__device__ __forceinline__ void attn_unit_fs(const bf16* __restrict__ Qb, const bf16* __restrict__ Kh, const bf16* __restrict__ Vh, bf16* __restrict__ Ob, int b, int t_begin, int NT, LAS char* lds, const int tid, const float bl2) {
    const int wid = tid >> 6, lane = tid & 63, r32 = lane & 31, hi = lane >> 5;
    LAS char* V_lds = lds + LDS_V; LAS char* K_lds = lds + LDS_K;
    f32x16 o[2] = {}; float l_reg = 0.f; bf16x8 qr[6]; const f32x16 negb = {};
    const bf16* Qw = Qb + (long)(wid * QBLK + r32) * 768 + hi * 8;
#pragma unroll
    for (int d0 = 0; d0 < 6; ++d0) qr[d0] = *reinterpret_cast<const bf16x8*>(Qw + d0 * 16);
    const bool kst = wid < 6;
    const int sr = tid / 12, scK = (tid % 12) * 8, vr = tid >> 3, scV = (tid & 7) * 8;
    const int kw0 = KSWZ(sr, scK * 2), kw1 = KSWZ(32 + sr, scK * 2), vw = v_st(vr, scV);
    const LAS char* vp0 = V_lds + (((lane & 3) << 3) | (((lane >> 2) & 3) << 6) | (((lane >> 4) & 1) << 5)) + hi * 1024;
    bf16x8 ks0, ks1, vs0;
    const unsigned kofB = (unsigned)(sr * 96 + scK) * 2u, vofB = (unsigned)(vr * 64 + scV) * 2u;
#define LDK(t) do { if (kst) { const int t_ = (t) < NT ? (t) : NT - 1; const char* kb_ = (const char*)Kh + (size_t)(t_begin + t_) * (64 * 192); \
    ks0 = *reinterpret_cast<const bf16x8*>(kb_ + kofB); ks1 = *reinterpret_cast<const bf16x8*>(kb_ + 32 * 192 + kofB); } } while (0)
#define LDV(t) do { const int t_ = (t) < NT ? (t) : NT - 1; const char* vb_ = (const char*)Vh + (size_t)(t_begin + t_) * (64 * 128); vs0 = *reinterpret_cast<const bf16x8*>(vb_ + vofB); } while (0)
#define WRK(bb) do { if (kst) { *(LAS bf16x8*)(K_lds + (bb) * SHM_K + kw0) = ks0; *(LAS bf16x8*)(K_lds + (bb) * SHM_K + kw1) = ks1; } } while (0)
#define WRV(bb) do { *(LAS bf16x8*)(V_lds + (bb) * SHM_V + vw) = vs0; } while (0)
    bf16x8 pa0, pa1, pa2, pa3;
    if (wid < 4) {
        f32x16 pA0, pA1, pB0, pB1;
        LDK(0); LDV(0); WRK(0); LDK(1); __syncthreads();
        qkt_fs(pA0, pA1, K_lds, qr, negb, r32, hi); WRK(1); WRV(0); LDK(2); LDV(1); __syncthreads();
        for (int j = 1; j + 1 < NT; j += 2) {
            qkt_fs(pB0, pB1, K_lds + SHM_K, qr, negb, r32, hi); expack(pA0, pA1, pa0, pa1, pa2, pa3, l_reg);
            pv3(o, vp0, pa0, pa1, pa2, pa3); WRK(0); WRV(1); LDK(j + 2); LDV(j + 1); __syncthreads();
            qkt_fs(pA0, pA1, K_lds, qr, negb, r32, hi); expack(pB0, pB1, pa0, pa1, pa2, pa3, l_reg);
            pv3(o, vp0 + SHM_V, pa0, pa1, pa2, pa3); WRK(1); WRV(0); LDK(j + 3); LDV(j + 2); __syncthreads();
        }
        qkt_fs(pB0, pB1, K_lds + SHM_K, qr, negb, r32, hi); expack(pA0, pA1, pa0, pa1, pa2, pa3, l_reg);
        pv3(o, vp0, pa0, pa1, pa2, pa3); WRV(1); __syncthreads();
        expack(pB0, pB1, pa0, pa1, pa2, pa3, l_reg);
        pv3(o, vp0 + SHM_V, pa0, pa1, pa2, pa3);
    } else {
        f32x16 p0, p1;
        LDK(0); LDV(0); WRK(0); LDK(1); __syncthreads();
        qkt_fs(p0, p1, K_lds, qr, negb, r32, hi); expack(p0, p1, pa0, pa1, pa2, pa3, l_reg); WRK(1); WRV(0); LDK(2); LDV(1); __syncthreads();
        for (int j = 1; j + 1 < NT; j += 2) {
            pv3(o, vp0, pa0, pa1, pa2, pa3);
            qkt_fs(p0, p1, K_lds + SHM_K, qr, negb, r32, hi); expack(p0, p1, pa0, pa1, pa2, pa3, l_reg);
            WRK(0); WRV(1); LDK(j + 2); LDV(j + 1); __syncthreads();
            pv3(o, vp0 + SHM_V, pa0, pa1, pa2, pa3);
            qkt_fs(p0, p1, K_lds, qr, negb, r32, hi); expack(p0, p1, pa0, pa1, pa2, pa3, l_reg);
            WRK(1); WRV(0); LDK(j + 3); LDV(j + 2); __syncthreads();
        }
        pv3(o, vp0, pa0, pa1, pa2, pa3);
        qkt_fs(p0, p1, K_lds + SHM_K, qr, negb, r32, hi); expack(p0, p1, pa0, pa1, pa2, pa3, l_reg);
        WRV(1); __syncthreads();
        pv3(o, vp0 + SHM_V, pa0, pa1, pa2, pa3);
    }
    { auto rr = __builtin_amdgcn_permlane32_swap(__float_as_uint(l_reg), __float_as_uint(l_reg), false, false); l_reg = __uint_as_float(rr[0]) + __uint_as_float(rr[1]); }
    LAS float* li_l = (LAS float*)(lds + LDS_WS) + wid * 64;
    if (hi == 0) li_l[r32] = l_reg;
    bf16* Ow = Ob + (long)(wid * QBLK) * 512;
#pragma unroll
    for (int r = 0; r < 16; ++r) { const int orow = crow(r, hi); const float rl = __builtin_amdgcn_rcpf(li_l[orow]);
#pragma unroll
        for (int d0 = 0; d0 < 2; ++d0) Ow[(long)orow * 512 + d0 * 32 + r32] = (bf16)(pk2(o[d0][r] * rl, 0.f) & 0xffffu); }
    __syncthreads();
#undef LDK
#undef LDV
#undef WRK
#undef WRV
}

typedef f32x4 acc4;
#define MF16(a_, b_, c_) __builtin_amdgcn_mfma_f32_16x16x32_bf16(a_, b_, c_, 0, 0, 0)
__device__ __forceinline__ void qkt16(acc4 (&s)[2][4], const LAS char* Ks, int kb0, int kb1, const bf16x8 (&qf)[2][3]) {
    const acc4 z4 = {0.f, 0.f, 0.f, 0.f};
#pragma unroll
    for (int ks = 0; ks < 3; ++ks)
#pragma unroll
        for (int kg = 0; kg < 4; ++kg) { const bf16x8 kf = *(const LAS bf16x8*)(Ks + ((ks & 1) ? kb1 : kb0) + kg * 4096 + (ks >> 1) * 128);
#pragma unroll
            for (int a = 0; a < 2; ++a) s[a][kg] = MF16(kf, qf[a][ks], ks == 0 ? z4 : s[a][kg]); }
}
__device__ __forceinline__ void expack16(acc4 (&s)[2][4], bf16x8 (&pa)[2][2], float (&l)[2]) {
#pragma unroll
    for (int a = 0; a < 2; ++a) { f32x2 t0 = {0.f, 0.f}, t1 = {0.f, 0.f};
#pragma unroll
        for (int kg = 0; kg < 4; ++kg) {
#pragma unroll
            for (int r = 0; r < 4; ++r) s[a][kg][r] = __builtin_amdgcn_exp2f(s[a][kg][r]);
            t0 += (f32x2){s[a][kg][0], s[a][kg][1]}; t1 += (f32x2){s[a][kg][2], s[a][kg][3]}; }
        t0 += t1; l[a] += t0.x + t0.y;
#pragma unroll
        for (int kb = 0; kb < 2; ++kb) { const acc4 u = s[a][2 * kb], v = s[a][2 * kb + 1];
            u32x4 w = {pk2(u[0], u[1]), pk2(u[2], u[3]), pk2(v[0], v[1]), pk2(v[2], v[3])}; pa[a][kb] = __builtin_bit_cast(bf16x8, w); } }
}
__device__ __forceinline__ void pv16(acc4 (&o)[4][2], const LAS char* vp, const bf16x8 (&pa)[2][2]) {
#pragma unroll
    for (int kb = 0; kb < 2; ++kb)
#pragma unroll
        for (int dg = 0; dg < 4; ++dg) { const LAS char* p = vp + kb * 4096 + (dg >> 1) * 512 + (dg & 1) * 32;
            const s16x4 lo = vtr(p), hi = vtr(p + 2048); const bf16x8 vf = {lo[0], lo[1], lo[2], lo[3], hi[0], hi[1], hi[2], hi[3]};
#pragma unroll
            for (int a = 0; a < 2; ++a) o[dg][a] = MF16(vf, pa[a][kb], o[dg][a]); }
}
__device__ __forceinline__ void attn_unit_m16(const bf16* __restrict__ Qb, const bf16* __restrict__ Kh, const bf16* __restrict__ Vh, bf16* __restrict__ Ob, int t_begin, int NT, LAS char* lds, const int tid) {
    const int wid = tid >> 6, lane = tid & 63, g = lane >> 4, j = lane & 15;
    LAS char* V_lds = lds; LAS char* K_lds = lds + 3 * SHM_V;
    acc4 o[4][2]; float l[2] = {0.f, 0.f}; bf16x8 qf[2][3];
#pragma unroll
    for (int dg = 0; dg < 4; ++dg)
#pragma unroll
        for (int a = 0; a < 2; ++a) o[dg][a] = (acc4){0.f, 0.f, 0.f, 0.f};
#pragma unroll
    for (int a = 0; a < 2; ++a)
#pragma unroll
        for (int ks = 0; ks < 3; ++ks) qf[a][ks] = *reinterpret_cast<const bf16x8*>(Qb + (long)(wid * QBLK + 16 * a + j) * 768 + 32 * ks + 8 * g);
    const int tl = tid & 255, idH0 = tl, idH1 = tl + 256, idL = tl + 512;
    const int vr = tid >> 3, scV = (tid & 7) * 8;
    const int kwH0 = KSWZ(idH0 / 12, (idH0 % 12) * 16), kwH1 = KSWZ(idH1 / 12, (idH1 % 12) * 16), kwL = KSWZ(idL / 12, (idL % 12) * 16), vw = v_st(vr, scV);
    const int kb0 = j * 256 + ((g ^ (j & 7)) * 16), kb1 = j * 256 + (((4 | g) ^ (j & 7)) * 16);
    const LAS char* vp0 = V_lds + (g & 1) * 1024 + ((((lane >> 2) & 3) + 4 * (g >> 1)) * 64) + (lane & 3) * 8;
    bf16x8 ks0, ks1, vs0;
    const unsigned kofH0 = (unsigned)idH0 * 16u, kofH1 = (unsigned)idH1 * 16u, kofL = (unsigned)idL * 16u, vofB = (unsigned)(vr * 64 + scV) * 2u;
#define LDK(t, P) do { const int t_ = (t) < NT ? (t) : NT - 1; const char* kb_ = (const char*)Kh + (size_t)(t_begin + t_) * (64 * 192); \
    if (HALF == (P)) { ks0 = *reinterpret_cast<const bf16x8*>(kb_ + kofH0); ks1 = *reinterpret_cast<const bf16x8*>(kb_ + kofH1); } else ks0 = *reinterpret_cast<const bf16x8*>(kb_ + kofL); } while (0)
#define LDV(t) do { const int t_ = (t) < NT ? (t) : NT - 1; const char* vb_ = (const char*)Vh + (size_t)(t_begin + t_) * (64 * 128); vs0 = *reinterpret_cast<const bf16x8*>(vb_ + vofB); } while (0)
#define WRK(bb) do { if (HALF == (bb)) { *(LAS bf16x8*)(K_lds + (bb) * SHM_K + kwH0) = ks0; *(LAS bf16x8*)(K_lds + (bb) * SHM_K + kwH1) = ks1; } else *(LAS bf16x8*)(K_lds + (bb) * SHM_K + kwL) = ks0; } while (0)
#define WRV(off) do { *(LAS bf16x8*)(V_lds + (off) + vw) = vs0; } while (0)
#define VROT() do { vprev = vcur; vcur = (vcur == 2 * SHM_V) ? 0 : vcur + SHM_V; } while (0)
#define A_BODY() do { acc4 pA[2][4], pB[2][4]; int vcur = 0, vprev = 0; \
        LDK(0, 0); LDV(0); WRK(0); LDK(1, 1); __syncthreads(); \
        qkt16(pA, K_lds, kb0, kb1, qf); WRK(1); WRV(vcur); LDK(2, 0); LDV(1); __syncthreads(); VROT(); \
        for (int jt = 1; jt + 1 < NT; jt += 2) { \
            qkt16(pB, K_lds + SHM_K, kb0, kb1, qf); WRK(0); LDK(jt + 2, 1); WRV(vcur); LDV(jt + 1); expack16(pA, pa, l); __syncthreads(); \
            pv16(o, vp0 + vprev, pa); VROT(); \
            qkt16(pA, K_lds, kb0, kb1, qf); WRK(1); LDK(jt + 3, 0); WRV(vcur); LDV(jt + 2); expack16(pB, pa, l); __syncthreads(); \
            pv16(o, vp0 + vprev, pa); VROT(); \
        } \
        qkt16(pB, K_lds + SHM_K, kb0, kb1, qf); WRV(vcur); expack16(pA, pa, l); __syncthreads(); \
        pv16(o, vp0 + vprev, pa); VROT(); \
        expack16(pB, pa, l); \
        pv16(o, vp0 + vprev, pa); } while (0)
    bf16x8 pa[2][2];
    if (wid < 4) { constexpr int HALF = 0; A_BODY(); }
    else { constexpr int HALF = 1; A_BODY(); }
#pragma unroll
    for (int a = 0; a < 2; ++a) { float t = l[a]; t += __shfl_xor(t, 16); t += __shfl_xor(t, 32); const float rl = __builtin_amdgcn_rcpf(t);
        bf16* orow = Ob + (long)(wid * QBLK + 16 * a + j) * 512 + 4 * g;
#pragma unroll
        for (int dg = 0; dg < 4; ++dg) { u32x2 w = {pk2(o[dg][a][0] * rl, o[dg][a][1] * rl), pk2(o[dg][a][2] * rl, o[dg][a][3] * rl)}; *(u32x2*)(orow + 16 * dg) = w; } }
    __syncthreads();
#undef LDK
#undef LDV
#undef WRK
#undef WRV
#undef VROT
#undef A_BODY
}
#undef MF16
#undef SBAR
}

#define XB_TMO      128
#define XB_XCNT(j)  (256  + 64 * (j))
#define XB_XSUB(j)  (1280 + 64 * (j))
#define XB_XGEN(j)  (2304 + 64 * (j))
#define XB_TOP      3328
#define XB_TOPGEN   3392
#define XCD_BAR_WORDS 3456
#define XB_SPIN_CAP (1u << 18)
__device__ __forceinline__ unsigned xb_ld(unsigned* p)              { return __hip_atomic_load(p, __ATOMIC_RELAXED, __HIP_MEMORY_SCOPE_AGENT); }
__device__ __forceinline__ unsigned xb_add(unsigned* p, unsigned v) { return __hip_atomic_fetch_add(p, v, __ATOMIC_RELAXED, __HIP_MEMORY_SCOPE_AGENT); }
__device__ __forceinline__ unsigned xb_xcc_id() { return (unsigned)__builtin_amdgcn_s_getreg((3 << 11) | 20) & 0xFu; }
#define XB_SPIN(cond, bar) do { unsigned _sp = 0; while (cond) { __builtin_amdgcn_s_sleep(1); \
    if ((++_sp & 255u) == 0u) { if (xb_ld(&(bar)[XB_TMO])) break; if (_sp > XB_SPIN_CAP) { atomicAdd(&(bar)[XB_TMO], 1u); break; } } } } while (0)
struct XcdBarrier { unsigned* bar; unsigned x; volatile LAS unsigned* st; };
__device__ __forceinline__ void xcd_barrier_complete(unsigned* bar, unsigned x, unsigned& nloc, unsigned& nx) {
    const unsigned G = gridDim.x * gridDim.y * gridDim.z;
    unsigned sum, cnt, mine, sp = 0u;
    for (;;) {
        sum = 0u; cnt = 0u; mine = 0u;
#pragma unroll
        for (unsigned j = 0; j < 16; ++j) { const unsigned c = xb_ld(&bar[XB_XCNT(j)]); sum += c; cnt += (c > 0u) ? 1u : 0u; mine = (j == x) ? c : mine; }
        if (sum == G) break;
        __builtin_amdgcn_s_sleep(1);
        if ((++sp & 255u) == 0u) { if (xb_ld(&bar[XB_TMO])) break; if (sp > XB_SPIN_CAP) { atomicAdd(&bar[XB_TMO], 1u); break; } }
    }
    nloc = mine > 0u ? mine : 1u; nx = cnt > 0u ? cnt : 1u;
}
__device__ __forceinline__ void xcd_barrier(const XcdBarrier& b) {
    asm volatile("s_waitcnt vmcnt(0)" ::: "memory");
    __syncthreads();
    if (threadIdx.x == 0) {
        unsigned* bar = b.bar;
        __builtin_amdgcn_s_waitcnt(0);
        unsigned nloc = b.st[0], nx = b.st[1];
        if (nloc == 0u) { xcd_barrier_complete(bar, b.x, nloc, nx); b.st[0] = nloc; b.st[1] = nx; }
        const unsigned old = xb_add(&bar[XB_XSUB(b.x)], 1u);
        const unsigned gen = old / nloc;
        if (old + 1u == (gen + 1u) * nloc) {
            __builtin_amdgcn_fence(__ATOMIC_RELEASE, "agent");
            asm volatile("s_waitcnt vmcnt(0)" ::: "memory");
            const unsigned og = xb_add(&bar[XB_TOP], 1u);
            const unsigned tg = og / nx;
            if (og + 1u == (tg + 1u) * nx) xb_add(&bar[XB_TOPGEN], 1u);
            else XB_SPIN(xb_ld(&bar[XB_TOPGEN]) == tg, bar);
            __builtin_amdgcn_fence(__ATOMIC_ACQUIRE, "agent");
            xb_add(&bar[XB_XGEN(b.x)], 1u);
            asm volatile("s_waitcnt vmcnt(0)" ::: "memory");
        } else {
            XB_SPIN(xb_ld(&bar[XB_XGEN(b.x)]) == gen, bar);
            __builtin_amdgcn_fence(__ATOMIC_ACQUIRE, "agent");
            asm volatile("s_waitcnt vmcnt(0)" ::: "memory");
        }
    }
    __syncthreads();
}

constexpr int LDS_BYTES = 147456;
constexpr int NPH_LAYER = 13 + (REPK >= 0 ? 1 : 0), NPHASES = 1 + 2 * NPH_LAYER;
struct Args { const float* in[26]; float* out; unsigned char* ws; int ph_lo, ph_hi; };

__device__ __forceinline__ void transpose_item(const float* W, int K, int Nsrc, bf16* WT, int Ndst, int mode, const float* rowscale, LAS float* scr, int item, int lane) {
    const int nblk = Ndst / 32, kb = item / nblk, nb = item % nblk, k0 = 64 * kb, n0 = 32 * nb;
    int src = n0; bool zero = false;
    if (mode == 1) src = ((n0 >> 7) & 1) * DFF + (n0 >> 8) * 128 + (n0 & 127); else zero = n0 >= Nsrc;
    f32x4 v[8];
#pragma unroll
    for (int i = 0; i < 8; ++i) { const int kk = 8 * i + (lane >> 3);
        v[i] = zero ? (f32x4){0.f, 0.f, 0.f, 0.f} : *(const f32x4*)(W + (size_t)(k0 + kk) * Nsrc + src + 4 * (lane & 7));
        if (rowscale) v[i] = v[i] * rowscale[k0 + kk]; }
#pragma unroll
    for (int i = 0; i < 8; ++i) { const int kk = 8 * i + (lane >> 3); LAS float* d = scr + kk * 33 + 4 * (lane & 7); d[0] = v[i].x; d[1] = v[i].y; d[2] = v[i].z; d[3] = v[i].w; }
    asm volatile("s_waitcnt lgkmcnt(0)" ::: "memory");
    const int c = lane & 7;
#pragma unroll
    for (int j = 0; j < 4; ++j) { const int n = (lane >> 3) + 8 * j; const LAS float* s = scr + (8 * c) * 33 + n;
        u32x4 o; o.x = pk2(s[0 * 33], s[1 * 33]); o.y = pk2(s[2 * 33], s[3 * 33]); o.z = pk2(s[4 * 33], s[5 * 33]); o.w = pk2(s[6 * 33], s[7 * 33]);
        *(u32x4*)(WT + (size_t)(n0 + n) * K + k0 + 8 * c) = o; }
    asm volatile("s_waitcnt lgkmcnt(0)" ::: "memory");
}
__device__ __forceinline__ void sincos_d(double x, double& s, double& c) {
    const double k = __builtin_rint(x * 0.6366197723675814);
    double r = __builtin_fma(-k, 1.5707963267948966, x); r = __builtin_fma(-k, 6.123233995736766e-17, r);
    const double r2 = r * r;
    double sp = 1.0 / 6227020800.0; sp = sp * r2 - 1.0 / 39916800.0; sp = sp * r2 + 1.0 / 362880.0; sp = sp * r2 - 1.0 / 5040.0; sp = sp * r2 + 1.0 / 120.0; sp = sp * r2 - 1.0 / 6.0; sp = sp * r2 + 1.0; sp *= r;
    double cp = -1.0 / 87178291200.0; cp = cp * r2 + 1.0 / 479001600.0; cp = cp * r2 - 1.0 / 3628800.0; cp = cp * r2 + 1.0 / 40320.0; cp = cp * r2 - 1.0 / 720.0; cp = cp * r2 + 1.0 / 24.0; cp = cp * r2 - 0.5; cp = cp * r2 + 1.0;
    const int n = ((int)k) & 3;
    s = (n == 0) ? sp : (n == 1) ? cp : (n == 2) ? -sp : -cp;
    c = (n == 0) ? cp : (n == 1) ? -sp : (n == 2) ? -cp : sp;
}

__global__ void __launch_bounds__(512, 2) mk_fwd(Args args) {
    extern __shared__ __attribute__((aligned(16))) unsigned char lds_raw[];
    LAS unsigned char* lds = (LAS unsigned char*)lds_raw;
    cg::grid_group grid = cg::this_grid();
    const int ph_lo = args.ph_lo, ph_hi = args.ph_hi;
    volatile LAS unsigned* MISC = (volatile LAS unsigned*)(lds + 131072 + 64);
    if (threadIdx.x < 4) MISC[threadIdx.x] = 0u;
    __syncthreads();
    if (!MK_MULTI && threadIdx.x == 0) (void)xb_add(&((unsigned*)(args.ws + WS_CTL))[XB_XCNT(xb_xcc_id())], 1u);
    if (!MK_MULTI && ph_hi > 1) grid.sync();
    typedef const float* __attribute__((address_space(4))) const* in_tab_t;

    if (ph_lo == 0 && PHEN(0)) {
        int tid = threadIdx.x; asm volatile("" : "+v"(tid));
        int bx = blockIdx.x; asm volatile("" : "+s"(bx));
        const unsigned char __attribute__((address_space(4)))* kp = (const unsigned char __attribute__((address_space(4)))*)__builtin_amdgcn_kernarg_segment_ptr(); asm volatile("" : "+s"(kp));
        struct InTab { in_tab_t p; __device__ __forceinline__ const float* operator[](int i) const { return p[i]; } };
        struct ArgsV { InTab in; } args_v; args_v.in.p = (in_tab_t)kp;
#define args args_v
        float* out = *(float* const __attribute__((address_space(4)))*)(kp + 26 * 8);
        unsigned char* ws = *(unsigned char* const __attribute__((address_space(4)))*)(kp + 27 * 8);
        const int lane = tid & 63, wave = __builtin_amdgcn_readfirstlane(tid >> 6);
        const int G = gridDim.x, gw = bx * 8 + wave, NGW = G * 8;
        float* mod = (float*)(ws + WS_MOD); float* rope = (float*)(ws + WS_ROPE);
        float* HC = (float*)(ws + WS_HC); bf16* Abuf = (bf16*)(ws + WS_A);
        bf16* U = (bf16*)(ws + WS_R + R_U); bf16* MIX = (bf16*)(ws + WS_R + R_MIX); bf16* Obuf = (bf16*)(ws + WS_R + R_O);
        bf16* QRAW = (bf16*)(ws + WS_R + R_QRAW); bf16* KVRAW = (bf16*)(ws + WS_R + R_KVRAW); bf16* Kbuf = (bf16*)(ws + WS_R + R_K); bf16* Vbuf = (bf16*)(ws + WS_R + R_V);
        const float* x_in = args.in[0]; const float* ctx_in = args.in[2]; float* PART = (float*)(ws + WS_R + 200 * MiB);
            LAS float* scv = (LAS float*)lds;
            LAS float* red = (LAS float*)(lds + 20480);
            for (int i = tid; i < 5 * DM; i += 512) { const int s = i >> 10, k = i & 1023; const float v = s < 4 ? args.in[1][s * DM + k] : args.in[3][k]; scv[i] = fsilu(v); }
            __syncthreads();
            for (int chunk = bx; chunk < 288; chunk += G) {
                const int l = chunk / 144, n0 = (chunk % 144) * 64, kq = tid >> 4, cq = tid & 15;
                const float* wa = args.in[4] + (size_t)l * DM * ADA + n0 + 4 * cq;
                f32x4 acc[5];
#pragma unroll
                for (int s = 0; s < 5; ++s) acc[s] = (f32x4){0.f, 0.f, 0.f, 0.f};
#pragma unroll 4
                for (int i = 0; i < 32; ++i) { const int k = kq + 32 * i; const f32x4 w = *(const f32x4*)(wa + (size_t)k * ADA);
#pragma unroll
                    for (int s = 0; s < 5; ++s) acc[s] += w * scv[s * DM + k]; }
#pragma unroll
                for (int s = 0; s < 5; ++s)
#pragma unroll
                    for (int e = 0; e < 4; ++e) red[(kq * 5 + s) * 64 + 4 * cq + e] = acc[s][e];
                __syncthreads();
                if (tid < 320) { const int s = tid >> 6, col = tid & 63; float v = 0.f;
                    for (int q = 0; q < 32; ++q) v += red[(q * 5 + s) * 64 + col];
                    mod[(size_t)(l * 5 + s) * ADA + n0 + col] = v + args.in[5][l * ADA + n0 + col]; }
                __syncthreads();
            }
            { const int gt = bx * 512 + tid;
              if (gt < 1024) { const int pos = gt >> 3, j = gt & 7; const int e = j >> 1;
                  double base = (j & 1) ? 0.31622776601683794 : 1.0; base *= (e == 0 ? 1.0 : e == 1 ? 0.1 : e == 2 ? 0.01 : 0.001);
                  const float invf = (float)base; const float ang = (float)pos * invf; double s, c; sincos_d((double)ang, s, c);
                  rope[2 * gt] = (float)c; rope[2 * gt + 1] = (float)s; } }
            __syncthreads();
            for (int i = bx * 512 + tid; i < MCTX * DM / 4; i += G * 512) ((f32x4*)HC)[i] = ((const f32x4*)ctx_in)[i];
            LAS float* scr = (LAS float*)(lds + wave * 16384);
            constexpr int I_IN = 16 * 176, I_OUT = 44 * 32, I_MIX = 16 * 64, I_Q = 6 * 24, I_KV = 4 * 32, I_MO = 16 * 32;
            constexpr int I_LAYER = 2 * I_IN + 2 * I_OUT + I_MIX + I_Q + I_KV + I_MO;
            for (int it = gw; it < 2 * I_LAYER; it += NGW) {
                const int l = it / I_LAYER; int r = it % I_LAYER; unsigned char* wl = ws + WS_W + (size_t)l * W_LAYER;
                if (r < I_IN) { transpose_item(args.in[7] + (size_t)l * DM * 2 * DFF, DM, 2 * DFF, (bf16*)(wl + WO_FFN1IN), 2 * DFF, 1, nullptr, scr, r, lane); continue; } r -= I_IN;
                if (r < I_OUT) { transpose_item(args.in[8] + (size_t)l * DFF * DM, DFF, DM, (bf16*)(wl + WO_FFN1OUT), DM, 0, nullptr, scr, r, lane); continue; } r -= I_OUT;
                if (r < I_MIX) { transpose_item(args.in[10] + (size_t)l * DM * MIXN, DM, MIXN, (bf16*)(wl + WO_MIXIN), MIXP, 0, nullptr, scr, r, lane); continue; } r -= I_MIX;
                if (r < I_Q) { transpose_item(args.in[12] + (size_t)l * QLORA * 768, QLORA, 768, (bf16*)(wl + WO_QUP), 768, 0, args.in[11] + l * QLORA, scr, r, lane); continue; } r -= I_Q;
                if (r < I_KV) { transpose_item(args.in[14] + (size_t)l * KVLORA * 1024, KVLORA, 1024, (bf16*)(wl + WO_KVUP), 1024, 0, args.in[13] + l * KVLORA, scr, r, lane); continue; } r -= I_KV;
                if (r < I_MO) { transpose_item(args.in[22] + (size_t)l * DM * DM, DM, DM, (bf16*)(wl + WO_MIXOUT), DM, 0, nullptr, scr, r, lane); continue; } r -= I_MO;
                if (r < I_IN) { transpose_item(args.in[24] + (size_t)l * DM * 2 * DFF, DM, 2 * DFF, (bf16*)(wl + WO_FFN2IN), 2 * DFF, 1, nullptr, scr, r, lane); continue; } r -= I_IN;
                transpose_item(args.in[25] + (size_t)l * DFF * DM, DFF, DM, (bf16*)(wl + WO_FFN2OUT), DM, 0, nullptr, scr, r, lane);
            }
#undef args
        if (ph_hi > 1) { XcdBarrier xb; xb.bar = (unsigned*)(args.ws + WS_CTL); xb.x = xb_xcc_id(); xb.st = MISC; xcd_barrier(xb); }
    }
    for (int ph = (ph_lo < 1 ? 1 : ph_lo); ph < ph_hi; ++ph) {
        int tid = threadIdx.x; asm volatile("" : "+v"(tid));
        int bx = blockIdx.x; asm volatile("" : "+s"(bx));
        const unsigned char __attribute__((address_space(4)))* kp = (const unsigned char __attribute__((address_space(4)))*)__builtin_amdgcn_kernarg_segment_ptr(); asm volatile("" : "+s"(kp));
        struct InTab { in_tab_t p; __device__ __forceinline__ const float* operator[](int i) const { return p[i]; } };
        struct ArgsV { InTab in; } args_v; args_v.in.p = (in_tab_t)kp;
#define args args_v
        float* out = *(float* const __attribute__((address_space(4)))*)(kp + 26 * 8);
        unsigned char* ws = *(unsigned char* const __attribute__((address_space(4)))*)(kp + 27 * 8);
        const int lane = tid & 63, wave = __builtin_amdgcn_readfirstlane(tid >> 6);
        const int G = gridDim.x, gw = bx * 8 + wave, NGW = G * 8;
        float* mod = (float*)(ws + WS_MOD); float* rope = (float*)(ws + WS_ROPE);
        float* HC = (float*)(ws + WS_HC); bf16* Abuf = (bf16*)(ws + WS_A);
        bf16* U = (bf16*)(ws + WS_R + R_U); bf16* MIX = (bf16*)(ws + WS_R + R_MIX); bf16* Obuf = (bf16*)(ws + WS_R + R_O);
        bf16* QRAW = (bf16*)(ws + WS_R + R_QRAW); bf16* KVRAW = (bf16*)(ws + WS_R + R_KVRAW); bf16* Kbuf = (bf16*)(ws + WS_R + R_K); bf16* Vbuf = (bf16*)(ws + WS_R + R_V);
        const float* x_in = args.in[0]; const float* ctx_in = args.in[2]; float* PART = (float*)(ws + WS_R + 200 * MiB);
        {
            const int l = (ph - 1) / NPH_LAYER, slot = (ph - 1) % NPH_LAYER, k = (REPK >= 0 && slot > REPK) ? slot - 1 : slot; const bool last = (l == 1);
            unsigned char* wl = ws + WS_W + (size_t)l * W_LAYER; const float* modl = mod + (size_t)l * 5 * ADA;
            const float* h_lat = (l == 0 && k <= 2) ? x_in : out; const float* h_ctx = HC;
            if ((k == 0 || k == 3 || k == 10) && PHEN(1)) {
                const int ch = (k == 0) ? 0 : (k == 3) ? 3 : 6; const float* g = (k == 0 ? args.in[6] : k == 3 ? args.in[9] : args.in[23]) + l * DM;
                const int nrows = (k == 10 && last) ? MLAT : MTOT;
                const int nsp = (k == 0) ? (l == 1 ? 11 : 0) : (k == 3) ? 11 : (last ? 0 : 4);
#pragma unroll 2
                for (int row = gw; row < nrows; row += NGW) {
                    const bool lat = row < MLAT; const float* src = lat ? h_lat + (size_t)row * DM : h_ctx + (size_t)(row - MLAT) * DM; const int s = lat ? (row >> 13) : 4;
                    const float* sh = modl + (size_t)s * ADA + ch * DM; const float* sc = sh + DM;
                    f32x4 v[4]; float ss = 0.f;
#pragma unroll
                    for (int j = 0; j < 4; ++j) v[j] = *(const f32x4*)(src + 4 * lane + 256 * j);
                    if (!lat && nsp) {
                        for (int sp = 0; sp < nsp; ++sp) { const float* pr = PART + (size_t)sp * ((size_t)MCTX * DM) + (size_t)(row - MLAT) * DM + 4 * lane;
#pragma unroll
                            for (int j = 0; j < 4; ++j) v[j] += *(const f32x4*)(pr + 256 * j); }
#pragma unroll
                        for (int j = 0; j < 4; ++j) *(f32x4*)(HC + (size_t)(row - MLAT) * DM + 4 * lane + 256 * j) = v[j];
                    }
#pragma unroll
                    for (int j = 0; j < 4; ++j) ss += (v[j].x * v[j].x + v[j].y * v[j].y) + (v[j].z * v[j].z + v[j].w * v[j].w);
                    const float rstd = __builtin_amdgcn_rsqf(wave_sum(ss) * (1.f / DM) + EPS);
#pragma unroll
                    for (int j = 0; j < 4; ++j) { const int c = 4 * lane + 256 * j; const f32x4 gg = *(const f32x4*)(g + c), s1 = *(const f32x4*)(sc + c), s0 = *(const f32x4*)(sh + c);
                        const f32x4 o = v[j] * rstd * gg * (s1 + 1.f) + s0; u32x2 w; w.x = pk2(o.x, o.y); w.y = pk2(o.z, o.w); *(u32x2*)(Abuf + (size_t)row * DM + c) = w; }
                }
            } else if ((k == 1 || k == 11) && PHEN(2)) {
                pg8::Gemm g{Abuf, (const bf16*)(wl + (k == 1 ? WO_FFN1IN : WO_FFN2IN)), (k == 11 && last) ? MLAT : MTOT, 2 * DFF, DM, DM};
                pg8::StaticOrder S; S.init(g.M, g.N, g.K, G, bx); pg8::EpiSwiGLU E{U, DFF};
                pg8::gemm_phase<pg8::EpiSwiGLU>(lds, g, S, E, tid);
            } else if ((k == 2 || k == 9 || k == 12) && PHEN(3)) {
                const bf16* Bt = (const bf16*)(wl + (k == 2 ? WO_FFN1OUT : k == 9 ? WO_MIXOUT : WO_FFN2OUT));
                pg8::Gemm g{k == 9 ? Abuf : U, Bt, (k != 2 && last) ? MLAT : MTOT, DM, k == 9 ? DM : DFF, k == 9 ? DM : DFF};
                pg8::StaticOrder S; S.init(g.M, g.N, g.K, G, bx, g.M - MLAT, 4);
                pg8::EpiResid E{h_lat, HC, out, HC, modl + (k == 2 ? 2 : k == 9 ? 5 : 8) * DM, k == 9 ? 1.f : 0.5f, g.K / pg8::BK, PART};
                pg8::gemm_phase<pg8::EpiResid>(lds, g, S, E, tid);
            } else if (k == 4 && PHEN(4)) {
                pg8::Gemm g{Abuf, (const bf16*)(wl + WO_MIXIN), MTOT, MIXP, DM, DM};
                pg8::StaticOrder S; S.init(g.M, g.N, g.K, G, bx); pg8::EpiStore E{MIX, MIXP};
                pg8::gemm_phase<pg8::EpiStore>(lds, g, S, E, tid);
            } else if (k == 5 && PHEN(5)) {
                { pg8::Gemm g{MIX, (const bf16*)(wl + WO_QUP), last ? MLAT : MTOT, 768, QLORA, MIXP};
                  pg8::StaticOrder S; S.init(g.M, g.N, g.K, G, bx); pg8::EpiStore E{QRAW, 768};
                  pg8::gemm_phase<pg8::EpiStore>(lds, g, S, E, tid); }
                { pg8::Gemm g{MIX + OFF_KV, (const bf16*)(wl + WO_KVUP), MTOT, 1024, KVLORA, MIXP};
                  pg8::StaticOrder S; S.init(g.M, g.N, g.K, G, (bx + 116) % G); pg8::EpiStore E{KVRAW, 1024};
                  pg8::gemm_phase<pg8::EpiStore>(lds, g, S, E, tid); }
            } else if (k == 6 && PHEN(6)) {
                const float* g_out = args.in[21] + l * DM;
                const int nchunk = last ? MLAT / 128 : MTOT / 128;
                LAS bf16* vT = (LAS bf16*)lds;
                for (int ci = bx; ci < nchunk; ci += G) {
                    { const int q = tid >> 2, gI = tid & 3; const bf16* src = MIX + (size_t)(ci * 128 + q) * MIXP + OFF_SG + 256 + gI * 64;
                      float vv[64]; float ss = 0.f;
#pragma unroll
                      for (int i = 0; i < 8; ++i) { const u32x4 w = *(const u32x4*)(src + 8 * i);
#pragma unroll
                          for (int e = 0; e < 4; ++e) { const float a = fgelu(bflo(w[e])), b2 = fgelu(bfhi(w[e])); vv[8 * i + 2 * e] = a; vv[8 * i + 2 * e + 1] = b2; ss += a * a + b2 * b2; } }
                      const float rs = __builtin_amdgcn_rsqf(ss * (1.f / 64.f) + EPS); const float* gs = args.in[17] + l * 256 + gI * 64;
#pragma unroll
                      for (int c = 0; c < 64; ++c) vT[(gI * 64 + c) * 136 + q] = (bf16)(pk2(vv[c] * rs * gs[c], 0.f) & 0xffffu); }
                    __syncthreads();
                    { const int fr = lane & 15, fq = lane >> 4, p0 = 16 * wave;
                      float ssr[4] = {0.f, 0.f, 0.f, 0.f};
                      f32x4 acc[4][4];
#pragma unroll
                      for (int gI = 0; gI < 4; ++gI) {
#pragma unroll
                          for (int nt = 0; nt < 4; ++nt) acc[gI][nt] = (f32x4){0.f, 0.f, 0.f, 0.f};
                          const float* wsp = args.in[18] + ((size_t)(l * 4 + gI) * 128 + p0 + fr) * 128 + 8 * fq;
#pragma unroll
                          for (int ks = 0; ks < 4; ++ks) { const f32x4 w0 = *(const f32x4*)(wsp + 32 * ks), w1 = *(const f32x4*)(wsp + 32 * ks + 4);
                              u32x4 aw = {pk2(w0[0], w0[1]), pk2(w0[2], w0[3]), pk2(w1[0], w1[1]), pk2(w1[2], w1[3])}; const bf16x8 af = __builtin_bit_cast(bf16x8, aw);
#pragma unroll
                              for (int nt = 0; nt < 4; ++nt) { const bf16x8 bfr = *(const LAS bf16x8*)(vT + (gI * 64 + 16 * nt + fr) * 136 + 32 * ks + 8 * fq);
                                  acc[gI][nt] = __builtin_amdgcn_mfma_f32_16x16x32_bf16(af, bfr, acc[gI][nt], 0, 0, 0); } }
#pragma unroll
                          for (int r = 0; r < 4; ++r) { const int p = p0 + 4 * fq + r; const float bias = args.in[19][(l * 4 + gI) * 128 + p]; const bf16* up = MIX + (size_t)(ci * 128 + p) * MIXP + OFF_SG + gI * 64;
#pragma unroll
                              for (int nt = 0; nt < 4; ++nt) { const float uu = fgelu(bf1(up[16 * nt + fr])); const float ov = uu * (acc[gI][nt][r] + bias); acc[gI][nt][r] = ov; ssr[r] += ov * ov; } }
                      }
#pragma unroll
                      for (int r = 0; r < 4; ++r) { float s = ssr[r]; s += __shfl_xor(s, 1); s += __shfl_xor(s, 2); s += __shfl_xor(s, 4); s += __shfl_xor(s, 8); ssr[r] = __builtin_amdgcn_rsqf(s * (1.f / 256.f) + EPS); }
#pragma unroll
                      for (int gI = 0; gI < 4; ++gI)
#pragma unroll
                          for (int r = 0; r < 4; ++r) { const int p = p0 + 4 * fq + r; bf16* yp = Abuf + (size_t)(ci * 128 + p) * DM + 512 + gI * 64;
#pragma unroll
                              for (int nt = 0; nt < 4; ++nt) { const int c = 16 * nt + fr; yp[c] = (bf16)(pk2(acc[gI][nt][r] * ssr[r] * g_out[512 + gI * 64 + c], 0.f) & 0xffffu); } }
                    }
                    __syncthreads();
                }
                const int nq = last ? MLAT : MTOT, nsc = last ? MLAT : MTOT;
                const int hh = lane >> 3, j = lane & 7;
                const float* gqh = args.in[15] + l * DQK; const float* gkh = args.in[16] + l * DQK;
                float gq[12], gk[12];
#pragma unroll
                for (int i = 0; i < 8; ++i) { gq[i] = gqh[8 * j + i]; gk[i] = gkh[8 * j + i]; }
#pragma unroll
                for (int i = 0; i < 4; ++i) { gq[8 + i] = gqh[64 + 8 * i + j]; gk[8 + i] = gkh[64 + 8 * i + j]; }
#pragma unroll 4
                for (int row = gw; row < MTOT; row += NGW) {
                    const bool lat = row < MLAT; const int t = row & (SEQ - 1);
                    const bf16* mrow = MIX + (size_t)row * MIXP;
                    float cr = 1.f, sr = 0.f, cc = 1.f, sc = 0.f;
                    if (lat) { const f32x2 a = *(const f32x2*)(rope + 2 * ((t >> 6) * 8 + j)), b2 = *(const f32x2*)(rope + 2 * ((t & 63) * 8 + j)); cr = a.x; sr = a.y; cc = b2.x; sc = b2.y; }
                    float sq = 0.f, skv = 0.f;
                    if (lane < 48) { const u32x4 w = *(const u32x4*)(mrow + 8 * lane);
#pragma unroll
                        for (int e = 0; e < 4; ++e) { const float a = bflo(w[e]), b2 = bfhi(w[e]); sq += a * a + b2 * b2; } }
                    if (lane < 32) { const u32x4 w = *(const u32x4*)(mrow + OFF_KV + 8 * lane);
#pragma unroll
                        for (int e = 0; e < 4; ++e) { const float a = bflo(w[e]), b2 = bfhi(w[e]); skv += a * a + b2 * b2; } }
                    const float rq = __builtin_amdgcn_rsqf(wave_sum(sq) * (1.f / QLORA) + EPS), rkv = __builtin_amdgcn_rsqf(wave_sum(skv) * (1.f / KVLORA) + EPS);
                    if (row < nq) {
                        bf16* qp = QRAW + (size_t)row * 768 + hh * DQK;
                        const u32x4 w = *(const u32x4*)(qp + 8 * j); float z[12];
#pragma unroll
                        for (int e = 0; e < 4; ++e) { z[2 * e] = bflo(w[e]) * rq; z[2 * e + 1] = bfhi(w[e]) * rq; }
#pragma unroll
                        for (int i = 0; i < 4; ++i) z[8 + i] = bf1(qp[64 + 8 * i + j]) * rq;
                        float ss = 0.f;
#pragma unroll
                        for (int i = 0; i < 12; ++i) ss += z[i] * z[i];
                        ss += __shfl_xor(ss, 1); ss += __shfl_xor(ss, 2); ss += __shfl_xor(ss, 4);
                        const float hr = __builtin_amdgcn_rsqf(ss * (1.f / DQK) + EPS);
#pragma unroll
                        for (int i = 0; i < 12; ++i) z[i] *= hr * gq[i] * (att::SCALE * 1.4426950408889634f);
                        const float n0 = z[8] * cr - z[9] * sr, n1 = z[9] * cr + z[8] * sr, n2 = z[10] * cc - z[11] * sc, n3 = z[11] * cc + z[10] * sc;
                        u32x4 o; o.x = pk2(z[0], z[1]); o.y = pk2(z[2], z[3]); o.z = pk2(z[4], z[5]); o.w = pk2(z[6], z[7]);
                        *(u32x4*)(qp + 8 * j) = o;
                        qp[64 + j] = (bf16)(pk2(n0, 0.f) & 0xffffu); qp[72 + j] = (bf16)(pk2(n1, 0.f) & 0xffffu); qp[80 + j] = (bf16)(pk2(n2, 0.f) & 0xffffu); qp[88 + j] = (bf16)(pk2(n3, 0.f) & 0xffffu);
                    }
                    {
                        bf16* kvp = KVRAW + (size_t)row * 1024 + hh * 128;
                        const u32x4 w = *(const u32x4*)(kvp + 8 * j); float z[12];
#pragma unroll
                        for (int e = 0; e < 4; ++e) { z[2 * e] = bflo(w[e]) * rkv; z[2 * e + 1] = bfhi(w[e]) * rkv; }
#pragma unroll
                        for (int i = 0; i < 4; ++i) z[8 + i] = bf1(mrow[OFF_KPE + 8 * i + j]);
                        float ss = 0.f;
#pragma unroll
                        for (int i = 0; i < 12; ++i) ss += z[i] * z[i];
                        ss += __shfl_xor(ss, 1); ss += __shfl_xor(ss, 2); ss += __shfl_xor(ss, 4);
                        const float hr = __builtin_amdgcn_rsqf(ss * (1.f / DQK) + EPS);
#pragma unroll
                        for (int i = 0; i < 12; ++i) z[i] *= hr * gk[i];
                        const float n0 = z[8] * cr - z[9] * sr, n1 = z[9] * cr + z[8] * sr, n2 = z[10] * cc - z[11] * sc, n3 = z[11] * cc + z[10] * sc;
                        const int kb_ = lat ? (row >> 13) : ((row - MLAT) >> 8), ki_ = lat ? t : SEQ + ((row - MLAT) & (NCTX - 1));
                        bf16* kp = Kbuf + ((size_t)(kb_ * NH + hh) * (SEQ + NCTX) + ki_) * DQK;
                        u32x4 o; o.x = pk2(z[0], z[1]); o.y = pk2(z[2], z[3]); o.z = pk2(z[4], z[5]); o.w = pk2(z[6], z[7]);
                        *(u32x4*)(kp + 8 * j) = o;
                        kp[64 + j] = (bf16)(pk2(n0, 0.f) & 0xffffu); kp[72 + j] = (bf16)(pk2(n1, 0.f) & 0xffffu); kp[80 + j] = (bf16)(pk2(n2, 0.f) & 0xffffu); kp[88 + j] = (bf16)(pk2(n3, 0.f) & 0xffffu);
                        const u32x4 wv = *(const u32x4*)(kvp + 64 + 8 * j); u32x4 ov;
#pragma unroll
                        for (int e = 0; e < 4; ++e) ov[e] = pk2(bflo(wv[e]) * rkv, bfhi(wv[e]) * rkv);
                        *(u32x4*)(Vbuf + ((size_t)(kb_ * NH + hh) * (SEQ + NCTX) + ki_) * DV + 8 * j) = ov;
                    }
                    if (row < nsc) {
                        const int tt = lat ? t : (row & (NCTX - 1)); const int tmax = lat ? SEQ - 1 : NCTX - 1;
                        const float* wc = args.in[20] + l * 3 * 256 + 4 * lane;
                        f32x4 y = {0.f, 0.f, 0.f, 0.f};
#pragma unroll
                        for (int d = 0; d < 3; ++d) { const int t2 = tt + d - 1;
                            if (t2 >= 0 && t2 <= tmax) { const bf16* r2 = MIX + (size_t)(row + d - 1) * MIXP + OFF_CONV;
                                const u32x2 cg2 = *(const u32x2*)(r2 + 256 + 4 * lane), xi = *(const u32x2*)(r2 + 512 + 4 * lane); const f32x4 w4 = *(const f32x4*)(wc + d * 256);
                                y.x += w4.x * bflo(cg2.x) * bflo(xi.x); y.y += w4.y * bfhi(cg2.x) * bfhi(xi.x); y.z += w4.z * bflo(cg2.y) * bflo(xi.y); y.w += w4.w * bfhi(cg2.y) * bfhi(xi.y); } }
                        const u32x2 bg = *(const u32x2*)(mrow + OFF_CONV + 4 * lane);
                        y.x *= bflo(bg.x); y.y *= bfhi(bg.x); y.z *= bflo(bg.y); y.w *= bfhi(bg.y);
                        const float rs = __builtin_amdgcn_rsqf(wave_sum((y.x * y.x + y.y * y.y) + (y.z * y.z + y.w * y.w)) * (1.f / 256.f) + EPS);
                        const f32x4 gg = *(const f32x4*)(g_out + 768 + 4 * lane);
                        u32x2 o; o.x = pk2(y.x * rs * gg.x, y.y * rs * gg.y); o.y = pk2(y.z * rs * gg.z, y.w * rs * gg.w);
                        *(u32x2*)(Abuf + (size_t)row * DM + 768 + 4 * lane) = o;
                    }
                }
            } else if (k == 7 && PHEN(7)) {
                const int nlat = NB * NH * 32, nun = last ? nlat : nlat + NB * NH;
                float bl2;
                { const float* gqh = args.in[15] + l * DQK; const float* gkh = args.in[16] + l * DQK;
                  float a = fabsf(gqh[lane]), c = fabsf(gkh[lane]); if (lane < 32) { a = fmaxf(a, fabsf(gqh[64 + lane])); c = fmaxf(c, fabsf(gkh[64 + lane])); }
#pragma unroll
                  for (int o = 1; o < 64; o <<= 1) { a = fmaxf(a, __shfl_xor(a, o)); c = fmaxf(c, __shfl_xor(c, o)); }
                  bl2 = 1.02f * 96.f * a * c * (att::SCALE * 1.4426950408889634f); }
                const bool fastpath = bl2 <= 48.f;
                for (int u = bx; u < nun; u += G) {
                    int b, h, qrow0, tb, nt;
                    if (u < nlat) { const int rr = u / 256, i = u % 256; const int bh = (i & 7) * 4 + rr, qb = i >> 3; b = bh >> 3; h = bh & 7; qrow0 = b * SEQ + qb * 256; tb = 0; nt = 132; }
                    else { const int bh = u - nlat; b = bh >> 3; h = bh & 7; qrow0 = MLAT + b * NCTX; tb = 128; nt = 4; }
                    if (fastpath) att::attn_unit_m16(QRAW + (size_t)qrow0 * 768 + h * DQK, Kbuf + (size_t)(b * NH + h) * (SEQ + NCTX) * DQK, Vbuf + (size_t)(b * NH + h) * (SEQ + NCTX) * DV, Obuf + (size_t)qrow0 * 512 + h * DV, tb, nt, (LAS char*)lds, tid);
                    else att::attn_unit(QRAW + (size_t)qrow0 * 768 + h * DQK, Kbuf + (size_t)(b * NH + h) * (SEQ + NCTX) * DQK, Vbuf + (size_t)(b * NH + h) * (SEQ + NCTX) * DV, Obuf + (size_t)qrow0 * 512 + h * DV, b, tb, nt, (char*)lds_raw, tid);
                }
            } else if (k == 8 && PHEN(8)) {
                const float* g_out = args.in[21] + l * DM; const int nrows = last ? MLAT : MTOT;
#pragma unroll 2
                for (int row = gw; row < nrows; row += NGW) {
                    const u32x4 w = *(const u32x4*)(Obuf + (size_t)row * 512 + 8 * lane); float z[8]; float ss = 0.f;
#pragma unroll
                    for (int e = 0; e < 4; ++e) { z[2 * e] = bflo(w[e]); z[2 * e + 1] = bfhi(w[e]); ss += z[2 * e] * z[2 * e] + z[2 * e + 1] * z[2 * e + 1]; }
                    const float rs = __builtin_amdgcn_rsqf(wave_sum(ss) * (1.f / 512.f) + EPS);
                    const f32x4 g0 = *(const f32x4*)(g_out + 8 * lane), g1 = *(const f32x4*)(g_out + 8 * lane + 4);
                    u32x4 o; o.x = pk2(z[0] * rs * g0.x, z[1] * rs * g0.y); o.y = pk2(z[2] * rs * g0.z, z[3] * rs * g0.w); o.z = pk2(z[4] * rs * g1.x, z[5] * rs * g1.y); o.w = pk2(z[6] * rs * g1.z, z[7] * rs * g1.w);
                    *(u32x4*)(Abuf + (size_t)row * DM + 8 * lane) = o;
                }
            }
        }
#undef args
        if (ph + 1 < ph_hi) { XcdBarrier xb; xb.bar = (unsigned*)(ws + WS_CTL); xb.x = xb_xcc_id(); xb.st = MISC; xcd_barrier(xb); }
    }
}

extern "C" void kernel_launch(void* const* d_in, const int* in_sizes, int n_in, void* d_out, int out_size, void* d_ws, size_t ws_size, hipStream_t stream) {
    static int grid = 0;
    if (grid == 0) {
        if (n_in != 26 || in_sizes[0] != MLAT * DM || out_size != MLAT * DM || ws_size < WS_END) {
            fprintf(stderr, "kernel_launch: unexpected shapes (n_in %d, in0 %d, out %d, ws %zu, need %zu)\n", n_in, n_in > 0 ? in_sizes[0] : -1, out_size, ws_size, (size_t)WS_END); grid = -1; return; }
        int dev = 0, cus = 0, per_cu = 0;
        hipGetDevice(&dev); hipDeviceGetAttribute(&cus, hipDeviceAttributeMultiprocessorCount, dev);
        if (hipFuncSetAttribute((const void*)mk_fwd, hipFuncAttributeMaxDynamicSharedMemorySize, LDS_BYTES) != hipSuccess) { fprintf(stderr, "kernel_launch: hipFuncSetAttribute failed\n"); grid = -1; return; }
        if (hipOccupancyMaxActiveBlocksPerMultiprocessor(&per_cu, (const void*)mk_fwd, 512, LDS_BYTES) != hipSuccess || per_cu < 1) { fprintf(stderr, "kernel_launch: occupancy query gave %d\n", per_cu); per_cu = 1; }
        (void)hipGetLastError();
        grid = cus * per_cu;
        fprintf(stderr, "kernel_launch: grid %d (cus %d x %d)\n", grid, cus, per_cu);
    }
    if (grid < 0) return;
    if (hipMemsetAsync((char*)d_ws + WS_CTL, 0, CTL_BYTES, stream) != hipSuccess) { fprintf(stderr, "kernel_launch: memset failed\n"); return; }
    Args a{};
    for (int i = 0; i < 26; ++i) a.in[i] = (const float*)d_in[i];
    a.out = (float*)d_out; a.ws = (unsigned char*)d_ws;
#if MK_MULTI
    for (int p = 0; p < NPHASES; ++p) { a.ph_lo = p; a.ph_hi = p + 1; hipLaunchKernelGGL(mk_fwd, dim3(grid), dim3(512), LDS_BYTES, stream, a); }
#else
    a.ph_lo = 0; a.ph_hi = NPHASES;
    void* kargs[] = {&a};
    hipError_t e = hipLaunchCooperativeKernel((const void*)mk_fwd, dim3(grid), dim3(512), kargs, LDS_BYTES, stream);
    if (e != hipSuccess) fprintf(stderr, "kernel_launch: cooperative launch failed: %s (grid %d)\n", hipGetErrorString(e), grid);
#endif
}
```

```cpp
#include <hip/hip_runtime.h>
#include <hip/hip_cooperative_groups.h>
#include <cstdio>
#include <cstdint>
namespace cg = cooperative_groups;

#ifndef MK_MULTI
#define MK_MULTI 0
#endif

#ifndef PHMASK
#define PHMASK 0xFFFF
#endif
#define PHEN(n) (((PHMASK) >> (n)) & 1)
#ifndef REPK
#define REPK -1
#endif
#define LAS __attribute__((address_space(3)))
typedef unsigned short bf16;
typedef short bf16x8 __attribute__((ext_vector_type(8)));
typedef short s16x4 __attribute__((ext_vector_type(4)));
typedef float f32x4 __attribute__((ext_vector_type(4)));
typedef float f32x2 __attribute__((ext_vector_type(2)));
typedef float f32x16 __attribute__((ext_vector_type(16)));
typedef unsigned u32x4 __attribute__((ext_vector_type(4)));
typedef unsigned u32x2 __attribute__((ext_vector_type(2)));
typedef __bf16 bf16x2_t __attribute__((ext_vector_type(2)));

constexpr int DM = 1024, NB = 4, SEQ = 8192, NCTX = 256, DFF = 2816;
constexpr int MLAT = NB * SEQ, MCTX = NB * NCTX, MTOT = MLAT + MCTX;
constexpr int NH = 8, DQK = 96, DV = 64, QLORA = 384, KVLORA = 256;
constexpr int OFF_KV = 384, OFF_KPE = 640, OFF_SG = 672, OFF_CONV = 1184, MIXN = 1952, MIXP = 2048;
constexpr int ADA = 9 * DM;
constexpr float EPS = 1e-6f;

constexpr size_t MiB = 1u << 20;
constexpr size_t WS_MOD = 0, WS_ROPE = 1 * MiB, WS_CTL = 1 * MiB + 512 * 1024, CTL_BYTES = 16384, WS_W = 2 * MiB, W_LAYER = 41 * MiB;
constexpr size_t WO_FFN1IN = 0, WO_FFN1OUT = 11 * MiB, WO_MIXIN = WO_FFN1OUT + 5767168, WO_QUP = WO_MIXIN + 4 * MiB, WO_KVUP = WO_QUP + 589824,
                 WO_MIXOUT = WO_KVUP + 524288, WO_FFN2IN = WO_MIXOUT + 2 * MiB, WO_FFN2OUT = WO_FFN2IN + 11 * MiB;
static_assert(WO_FFN2OUT + 5767168 <= W_LAYER, "weights");
constexpr size_t WS_HC = 84 * MiB, WS_A = 88 * MiB, WS_R = 154 * MiB;
constexpr size_t R_U = 0, R_MIX = 0, R_O = 0  , R_V = 132 * MiB  , R_QRAW = 165 * MiB, R_KVRAW = R_QRAW + (size_t)MTOT * 768 * 2, R_K = R_KVRAW + 66 * MiB;
constexpr size_t WS_END = WS_R + R_K + (size_t)MTOT * 768 * 2;
static_assert(WS_END <= 512 * MiB, "ws");
static_assert((size_t)MTOT * DFF * 2 <= 330 * MiB, "U");

__device__ __forceinline__ unsigned pk2(float lo, float hi) { f32x2 v = {lo, hi}; bf16x2_t b = __builtin_convertvector(v, bf16x2_t); return __builtin_bit_cast(unsigned, b); }
__device__ __forceinline__ float bflo(unsigned w) { return __uint_as_float(w << 16); }
__device__ __forceinline__ float bfhi(unsigned w) { return __uint_as_float(w & 0xffff0000u); }
__device__ __forceinline__ float bf1(bf16 h) { return __uint_as_float((unsigned)h << 16); }
__device__ __forceinline__ float wave_sum(float v) {
#pragma unroll
    for (int o = 1; o < 64; o <<= 1) v += __shfl_xor(v, o);
    return v;
}
__device__ __forceinline__ float fsilu(float x) { return x * __builtin_amdgcn_rcpf(1.f + __builtin_amdgcn_exp2f(-1.4426950408889634f * x)); }
__device__ __forceinline__ float fgelu(float x) {
    const float z = 1.5957691216057308f * (x + 0.044715f * x * x * x);
    return x * __builtin_amdgcn_rcpf(1.f + __builtin_amdgcn_exp2f(-1.4426950408889634f * z));
}

namespace pg8 {
constexpr int BM = 256, BK = 64, HALF = 128, HTB = HALF * BK * 2, STAGE_BYTES = 8 * HTB, NXCD = 8, WGM = 8;
__host__ __device__ __forceinline__ int lds_byte(int r, int c) { const int st = (r >> 4) * 2 + (c >> 5), rr = r & 15, cc = c & 31, ob = rr * 64 + cc * 2; return st * 1024 + (ob ^ (((ob >> 9) & 1) << 5)); }
__host__ __device__ __forceinline__ void stage_rc(int b, int& R, int& C) { const int st = b / 1024, sb = b % 1024, swz = sb ^ (((sb >> 9) & 1) << 5); R = (st >> 1) * 16 + swz / 64; C = (st & 1) * 32 + (swz % 64) / 2; }
__host__ __device__ __forceinline__ int perm32(int rho) { const int n = rho >> 4, i = rho & 15; return 8 * (i >> 2) + 4 * n + (i & 3); }
struct Unit { int pm, pn, k0, nt; };
struct Gemm { const bf16* A; const bf16* Bt; int M, N, K, lda; };
struct StaticOrder {
    int nM, nN, nwg, G, c, ntfull, nsplit, ntsub, ntail;
    __device__ void init(int M, int N, int K, int G_, int c_, int Msplit = 0, int ntsub_ = 0) {
        nM = (M - Msplit) / BM; nN = N / BM; nwg = nM * nN; G = G_; c = c_; ntfull = K / BK;
        ntsub = ntsub_ > 0 ? ntsub_ : ntfull; nsplit = ntfull / ntsub; ntail = (Msplit / BM) * nN * nsplit; }
    __device__ bool next(int i, Unit& u) const {
        const long L = (long)i * G + c; if (L >= nwg + ntail) return false;
        if (L >= nwg) { const int s = (int)L - nwg, nt4 = (ntail / nsplit), tile = s % nt4, ks = s / nt4; u.pm = nM + tile / nN; u.pn = tile % nN; u.k0 = ks * ntsub; u.nt = ntsub; return true; }
        int wgid = (int)L; { const int q = nwg / NXCD, r = nwg % NXCD, xcd = wgid % NXCD, off = wgid / NXCD; wgid = (xcd < r ? xcd * (q + 1) : r * (q + 1) + (xcd - r) * q) + off; }
        const int nig = WGM * nN, gid = wgid / nig, fm = gid * WGM, gsz = (nM - fm) < WGM ? (nM - fm) : WGM;
        u.pm = fm + ((wgid % nig) % gsz); u.pn = (wgid % nig) / gsz; u.k0 = 0; u.nt = ntfull; return true;
    }
};
struct EpiStore {
    static constexpr bool PERM = true;
    bf16* O; int ldc;
    __device__ __forceinline__ void operator()(const f32x4 (&acc)[2][2][4][2], const Unit& u, int wr, int wc, int fr, int fq) const {
        const int row0 = u.pm * BM + wr * 64 + fr, col0 = u.pn * BM + wc * 32 + 8 * fq;
#pragma unroll
        for (int ai = 0; ai < 2; ++ai)
#pragma unroll
            for (int m = 0; m < 4; ++m) { bf16* rowp = O + (size_t)(row0 + ai * HALF + m * 16) * ldc + col0;
#pragma unroll
                for (int bj = 0; bj < 2; ++bj) { const f32x4 v0 = acc[ai][bj][m][0], v1 = acc[ai][bj][m][1];
                    u32x4 w; w.x = pk2(v0[0], v0[1]); w.y = pk2(v0[2], v0[3]); w.z = pk2(v1[0], v1[1]); w.w = pk2(v1[2], v1[3]);
                    *(u32x4*)(rowp + bj * HALF) = w; } }
    }
};
struct EpiSwiGLU {
    static constexpr bool PERM = true;
    bf16* U; int ldu;
    __device__ __forceinline__ void operator()(const f32x4 (&acc)[2][2][4][2], const Unit& u, int wr, int wc, int fr, int fq) const {
        const int row0 = u.pm * BM + wr * 64 + fr, col0 = u.pn * HALF + wc * 32 + 8 * fq;
#pragma unroll
        for (int ai = 0; ai < 2; ++ai)
#pragma unroll
            for (int m = 0; m < 4; ++m) { bf16* rowp = U + (size_t)(row0 + ai * HALF + m * 16) * ldu + col0;
                const f32x4 a0 = acc[ai][0][m][0], a1 = acc[ai][0][m][1], b0 = acc[ai][1][m][0], b1 = acc[ai][1][m][1];
                u32x4 w; w.x = pk2(fsilu(a0[0]) * b0[0], fsilu(a0[1]) * b0[1]); w.y = pk2(fsilu(a0[2]) * b0[2], fsilu(a0[3]) * b0[3]);
                w.z = pk2(fsilu(a1[0]) * b1[0], fsilu(a1[1]) * b1[1]); w.w = pk2(fsilu(a1[2]) * b1[2], fsilu(a1[3]) * b1[3]);
                *(u32x4*)rowp = w; }
    }
};
struct EpiResid {
    static constexpr bool PERM = true;
    const float* rin_lat; const float* rin_ctx; float* out_lat; float* out_ctx; const float* gate; float coef; int ntfull; float* part;
    __device__ __forceinline__ void operator()(const f32x4 (&acc)[2][2][4][2], const Unit& u, int wr, int wc, int fr, int fq) const {
        asm volatile("" : "+v"(fr), "+v"(fq));
        const bool lat = u.pm < MLAT / BM; const int s = lat ? (u.pm >> 5) : 4;
        const size_t tbase = lat ? (size_t)u.pm * BM * DM : (size_t)(u.pm - MLAT / BM) * BM * DM;
        const long long di = lat ? 0ll : (long long)((const char*)rin_ctx - (const char*)rin_lat), dq = lat ? 0ll : (long long)((char*)out_ctx - (char*)out_lat);
        const float* rin = (const float*)((const char*)rin_lat + di) + tbase; float* out = (float*)((char*)out_lat + dq) + tbase;
        const int col0 = u.pn * BM + wc * 32 + 8 * fq;
        if (u.nt != ntfull) {
            float* pp = part + (size_t)(u.k0 / u.nt) * ((size_t)MCTX * DM) + tbase;
#pragma unroll
            for (int bj = 0; bj < 2; ++bj) { const int col = col0 + bj * HALF; const f32x4 g0 = *(const f32x4*)(gate + (size_t)s * ADA + col) * coef, g1 = *(const f32x4*)(gate + (size_t)s * ADA + col + 4) * coef;
#pragma unroll
                for (int ai = 0; ai < 2; ++ai)
#pragma unroll
                    for (int m = 0; m < 4; ++m) { const size_t off = (size_t)(ai * HALF + wr * 64 + m * 16 + fr) * DM + col; *(f32x4*)(pp + off) = g0 * acc[ai][bj][m][0]; *(f32x4*)(pp + off + 4) = g1 * acc[ai][bj][m][1]; } }
            return;
        }
#pragma unroll
        for (int bj = 0; bj < 2; ++bj) { const int col = col0 + bj * HALF; const f32x4 g0 = *(const f32x4*)(gate + (size_t)s * ADA + col) * coef, g1 = *(const f32x4*)(gate + (size_t)s * ADA + col + 4) * coef;
#pragma unroll
            for (int ai = 0; ai < 2; ++ai) { f32x4 r[4][2];
#pragma unroll
                for (int m = 0; m < 4; ++m) { const size_t off = (size_t)(ai * HALF + wr * 64 + m * 16 + fr) * DM + col; r[m][0] = *(const f32x4*)(rin + off); r[m][1] = *(const f32x4*)(rin + off + 4); }
                asm volatile("" ::: "memory");
#pragma unroll
                for (int m = 0; m < 4; ++m) { const size_t off = (size_t)(ai * HALF + wr * 64 + m * 16 + fr) * DM + col;
                    *(f32x4*)(out + off) = r[m][0] + g0 * acc[ai][bj][m][0]; *(f32x4*)(out + off + 4) = r[m][1] + g1 * acc[ai][bj][m][1]; }
                asm volatile("" ::: "memory"); } }
    }
};

template <class Epi>
__device__ __forceinline__ void gemm_phase(LAS unsigned char* lds, const Gemm g, const StaticOrder& S, const Epi& E, const int tid) {
    const int wid = __builtin_amdgcn_readfirstlane(tid >> 6), lane = tid & 63, wr = wid >> 2, wc = wid & 3, fr = lane & 15, fq = lane >> 4;
    const int K = g.K, lda = g.lda;
    unsigned voffA[2], voffB[2];
#pragma unroll
    for (int i = 0; i < 2; ++i) { int R, C; stage_rc(tid * 16 + i * 8192, R, C); const int Rb = Epi::PERM ? ((R & ~31) + perm32(R & 31)) : R;
        voffA[i] = (unsigned)(R * lda + C) * 2u; voffB[i] = (unsigned)(Rb * K + C) * 2u; }
    const size_t kstep = (size_t)(BK * 2);
    const size_t hstepA = (size_t)HALF * lda * 2, hstepB = (size_t)HALF * K * 2;
    const size_t tstepA = 2 * hstepA, tstepB = 2 * hstepB;
    const unsigned ldsw = (unsigned)wid * 1024u;
    const int aoff = lds_byte(wr * 64 + fr, fq * 8), boff = lds_byte(wc * 32 + fr, fq * 8);
#define PG8_SA(b, h) (((b) * 2 + (h)) * HTB)
#define PG8_SB(b, h) ((4 + (b) * 2 + (h)) * HTB)
#define PG8_STAGE(bufoff, gbase, voff) do { _Pragma("unroll") for (int _i = 0; _i < 2; ++_i) \
        __builtin_amdgcn_global_load_lds((const unsigned*)((const char*)(gbase) + (voff)[_i]), (LAS unsigned*)(lds + (bufoff) + ldsw + _i * 8192), 16, 0, 0); } while (0)
#define PG8_LDA(dst, b, h) do { _Pragma("unroll") for (int m = 0; m < 4; ++m) _Pragma("unroll") for (int k = 0; k < 2; ++k) dst[m][k] = *(const LAS bf16x8*)(lds + PG8_SA(b, h) + aoff + m * 2048 + k * 1024); } while (0)
#define PG8_LDB(dst, b, h) do { _Pragma("unroll") for (int n = 0; n < 2; ++n) _Pragma("unroll") for (int k = 0; k < 2; ++k) dst[n][k] = *(const LAS bf16x8*)(lds + PG8_SB(b, h) + boff + n * 2048 + k * 1024); } while (0)
#define PG8_MMA(ai, bj, At, Bt) do { __builtin_amdgcn_s_setprio(1); _Pragma("unroll") for (int m = 0; m < 4; ++m) _Pragma("unroll") for (int n = 0; n < 2; ++n) _Pragma("unroll") for (int k = 0; k < 2; ++k) \
        acc[ai][bj][m][n] = __builtin_amdgcn_mfma_f32_16x16x32_bf16(Bt[n][k], At[m][k], acc[ai][bj][m][n], 0, 0, 0); __builtin_amdgcn_s_setprio(0); } while (0)
#define PG8_WAIT_V(n) asm volatile("s_waitcnt vmcnt(" #n ")" ::: "memory")
#define PG8_WAIT_L(n) asm volatile("s_waitcnt lgkmcnt(" #n ")" ::: "memory")
#define PG8_BAR __builtin_amdgcn_s_barrier()
#define PG8_SCHED __builtin_amdgcn_sched_barrier(0)
    Unit cur, nxt; int ui = 0;
    if (!S.next(0, cur)) return;
    f32x4 acc[2][2][4][2];
#pragma unroll
    for (int a = 0; a < 2; ++a)
#pragma unroll
        for (int b = 0; b < 2; ++b)
#pragma unroll
            for (int m = 0; m < 4; ++m)
#pragma unroll
                for (int n = 0; n < 2; ++n) acc[a][b][m][n] = (f32x4){0.f, 0.f, 0.f, 0.f};
    bf16x8 At[4][2], B0[2][2], B1[2][2];
    const char* cA = (const char*)g.A + (size_t)cur.pm * tstepA + (size_t)cur.k0 * kstep; const char* cB = (const char*)g.Bt + (size_t)cur.pn * tstepB + (size_t)cur.k0 * kstep;
    PG8_STAGE(PG8_SB(0, 0), cB, voffB); PG8_STAGE(PG8_SB(0, 1), cB + hstepB, voffB); PG8_STAGE(PG8_SA(0, 0), cA, voffA); PG8_STAGE(PG8_SA(0, 1), cA + hstepA, voffA);
    if (wr == 1) PG8_BAR;
    PG8_WAIT_V(2); PG8_BAR;
    PG8_STAGE(PG8_SB(1, 0), cB + kstep, voffB); PG8_STAGE(PG8_SA(1, 0), cA + kstep, voffA); PG8_STAGE(PG8_SB(1, 1), cB + hstepB + kstep, voffB);
    PG8_WAIT_V(6); PG8_BAR;
    for (;;) {
        const bool has_next = S.next(ui + 1, nxt);
        const char* nA = has_next ? (const char*)g.A + (size_t)nxt.pm * tstepA + (size_t)nxt.k0 * kstep : cA; const char* nB = has_next ? (const char*)g.Bt + (size_t)nxt.pn * tstepB + (size_t)nxt.k0 * kstep : cB;
        const int nt = cur.nt;
        for (int t = 0; t < nt; t += 2) {
            const bool last = (t == nt - 2);
            const char* a1 = cA + (size_t)(t + 1) * kstep;
            const char* a2 = last ? nA : cA + (size_t)(t + 2) * kstep; const char* b2 = last ? nB : cB + (size_t)(t + 2) * kstep;
            const char* a3 = a2 + kstep; const char* b3 = b2 + kstep;
            PG8_LDB(B0, 0, 0); PG8_LDB(B1, 0, 1); PG8_SCHED; PG8_LDA(At, 0, 0); PG8_STAGE(PG8_SA(1, 1), a1 + hstepA, voffA);
            PG8_WAIT_V(8); PG8_WAIT_L(0); PG8_BAR; PG8_MMA(0, 0, At, B0); PG8_MMA(0, 1, At, B1); PG8_BAR; PG8_SCHED;
            PG8_LDA(At, 0, 1); PG8_STAGE(PG8_SB(0, 0), b2, voffB); PG8_STAGE(PG8_SB(0, 1), b2 + hstepB, voffB); PG8_STAGE(PG8_SA(0, 0), a2, voffA);
            PG8_WAIT_V(8); PG8_WAIT_L(0); PG8_BAR; PG8_MMA(1, 0, At, B0); PG8_MMA(1, 1, At, B1); PG8_BAR; PG8_SCHED;
            PG8_LDB(B0, 1, 0); PG8_LDB(B1, 1, 1); PG8_SCHED; PG8_LDA(At, 1, 0); PG8_STAGE(PG8_SA(0, 1), a2 + hstepA, voffA);
            PG8_WAIT_V(8); PG8_WAIT_L(0); PG8_BAR; PG8_MMA(0, 0, At, B0); PG8_MMA(0, 1, At, B1); PG8_BAR; PG8_SCHED;
            PG8_LDA(At, 1, 1); PG8_STAGE(PG8_SB(1, 0), b3, voffB); PG8_STAGE(PG8_SB(1, 1), b3 + hstepB, voffB); PG8_STAGE(PG8_SA(1, 0), a3, voffA);
            PG8_WAIT_V(8); PG8_WAIT_L(0); PG8_BAR; PG8_MMA(1, 0, At, B0); PG8_MMA(1, 1, At, B1); PG8_BAR; PG8_SCHED;
        }
        if (wr == 0) PG8_BAR;
        E(acc, cur, wr, wc, fr, fq);
        if (!has_next) break;
#pragma unroll
        for (int a = 0; a < 2; ++a)
#pragma unroll
            for (int b = 0; b < 2; ++b)
#pragma unroll
                for (int m = 0; m < 4; ++m)
#pragma unroll
                    for (int n = 0; n < 2; ++n) acc[a][b][m][n] = (f32x4){0.f, 0.f, 0.f, 0.f};
        cur = nxt; cA = nA; cB = nB; ++ui;
        if (wr == 1) PG8_BAR;
    }
    PG8_WAIT_V(0);
    PG8_BAR;
#undef PG8_SA
#undef PG8_SB
#undef PG8_STAGE
#undef PG8_LDA
#undef PG8_LDB
#undef PG8_MMA
#undef PG8_WAIT_V
#undef PG8_WAIT_L
#undef PG8_BAR
#undef PG8_SCHED
}
}

namespace att {
constexpr int NW = 8, QBLK = 32, KVBLK = 64;
constexpr float SCALE = 0.10206207261596575f;
constexpr float THR = 8.f;
constexpr int SHM_V = KVBLK * DV * 2, SHM_K = KVBLK * 256;
constexpr int LDS_V = 0, LDS_K = 2 * SHM_V, LDS_WS = LDS_K + 2 * SHM_K, LDS_BYTES = LDS_WS + NW * 64 * 4;
#define KSWZ(row, colB) ((row) * 256 + ((colB) ^ (((row) & 7) << 4)))
#define SBAR() __builtin_amdgcn_sched_barrier(0)
__device__ __forceinline__ int crow(int r, int hi) { return (r & 3) + 8 * (r >> 2) + 4 * hi; }
__device__ __forceinline__ unsigned cvtpk(float lo, float hi) { unsigned r; asm volatile("v_cvt_pk_bf16_f32 %0, %1, %2" : "=v"(r) : "v"(lo), "v"(hi)); return r; }
__device__ __forceinline__ void partialSM(f32x16& p0, f32x16& p1, float& m_reg, float& mn, float& alpha) {
    constexpr float C = 1.0f;
    float pmax = p0[0];
#pragma unroll
    for (int r = 1; r < 16; ++r) pmax = fmaxf(pmax, p0[r]);
#pragma unroll
    for (int r = 0; r < 16; ++r) pmax = fmaxf(pmax, p1[r]);
    { auto rr = __builtin_amdgcn_permlane32_swap(__float_as_uint(pmax), __float_as_uint(pmax), false, false);
      pmax = fmaxf(__uint_as_float(rr[0]), __uint_as_float(rr[1])); }
    if (__builtin_expect(__all(pmax - m_reg <= THR * 1.4426950408889634f), 1)) { mn = m_reg; alpha = 1.f; }
    else { mn = fmaxf(m_reg, pmax); alpha = __builtin_amdgcn_exp2f((m_reg - mn) * C); m_reg = mn; }
    const float mnC = -mn * C;
#pragma unroll
    for (int r = 0; r < 16; ++r) p0[r] = fmaf(p0[r], C, mnC);
#pragma unroll
    for (int r = 0; r < 16; ++r) p1[r] = fmaf(p1[r], C, mnC);
#pragma unroll
    for (int r = 0; r < 16; ++r) p0[r] = __builtin_amdgcn_exp2f(p0[r]);
}
__device__ __forceinline__ void finishSM(f32x16& p0, f32x16& p1, float alpha, float& l_reg, bf16x8& pa0, bf16x8& pa1, bf16x8& pa2, bf16x8& pa3) {
#pragma unroll
    for (int r = 0; r < 16; ++r) p1[r] = __builtin_amdgcn_exp2f(p1[r]);
    float ps = 0;
#pragma unroll
    for (int r = 0; r < 16; ++r) ps += p0[r];
#pragma unroll
    for (int r = 0; r < 16; ++r) ps += p1[r];
    { auto rr = __builtin_amdgcn_permlane32_swap(__float_as_uint(ps), __float_as_uint(ps), false, false);
      ps = __uint_as_float(rr[0]) + __uint_as_float(rr[1]); }
    l_reg = l_reg * alpha + ps;
#define PK4(P, BASE, OUT) do { unsigned a0 = cvtpk(P[BASE + 0], P[BASE + 1]), a1 = cvtpk(P[BASE + 2], P[BASE + 3]);   \
    unsigned b0 = cvtpk(P[BASE + 4], P[BASE + 5]), b1 = cvtpk(P[BASE + 6], P[BASE + 7]);                              \
    auto r0 = __builtin_amdgcn_permlane32_swap(a0, b0, false, false); auto r1 = __builtin_amdgcn_permlane32_swap(a1, b1, false, false); \
    u32x4 w = {r0[0], r1[0], r0[1], r1[1]}; OUT = __builtin_bit_cast(bf16x8, w); } while (0)
    PK4(p0, 0, pa0); PK4(p0, 8, pa1); PK4(p1, 0, pa2); PK4(p1, 8, pa3);
#undef PK4
}
__device__ __forceinline__ void qkt(f32x16& p0, f32x16& p1, const char* Ks, const bf16x8* qr, int r32, int hi) {
    p0 = f32x16{}; p1 = f32x16{};
#pragma unroll
    for (int d0 = 0; d0 < 6; ++d0) { const int cb = (d0 * 16 + hi * 8) * 2;
        const bf16x8 b0 = *reinterpret_cast<const bf16x8*>(Ks + KSWZ(r32, cb));
        const bf16x8 b1 = *reinterpret_cast<const bf16x8*>(Ks + KSWZ(32 + r32, cb));
        p0 = __builtin_amdgcn_mfma_f32_32x32x16_bf16(b0, qr[d0], p0, 0, 0, 0);
        p1 = __builtin_amdgcn_mfma_f32_32x32x16_bf16(b1, qr[d0], p1, 0, 0, 0); }
}
__device__ __forceinline__ int v_st(int k, int c) { const int kk = (k & ~0xC) | ((k & 4) << 1) | ((k & 8) >> 1); return ((kk >> 3) * 2 + (c >> 5)) * 512 + ((kk & 7) * 32 + (c & 31)) * 2; }
__device__ __forceinline__ int v_rd_base(int lane) { return ((lane & 3) << 3) | (((lane >> 2) & 3) << 6) | (((lane >> 4) & 1) << 5) | (((lane >> 5) & 1) << 8); }
constexpr int v_rd_off(int d0, int ks, int half) { return d0 * 512 + ks * 2048 + half * 1024; }
template <int OFF> __device__ __forceinline__ s16x4 tr_read(int vb) { s16x4 r; asm volatile("ds_read_b64_tr_b16 %0, %1 offset:%2" : "=&v"(r) : "v"(vb), "i"(OFF) : "memory"); return r; }
template <int D0> __device__ __forceinline__ void pv_one(f32x16& od, int vb, bf16x8 pa0, bf16x8 pa1, bf16x8 pa2, bf16x8 pa3) {
    const s16x4 l0 = tr_read<v_rd_off(D0, 0, 0)>(vb), h0 = tr_read<v_rd_off(D0, 0, 1)>(vb), l1 = tr_read<v_rd_off(D0, 1, 0)>(vb), h1 = tr_read<v_rd_off(D0, 1, 1)>(vb);
    const s16x4 l2 = tr_read<v_rd_off(D0, 2, 0)>(vb), h2 = tr_read<v_rd_off(D0, 2, 1)>(vb), l3 = tr_read<v_rd_off(D0, 3, 0)>(vb), h3 = tr_read<v_rd_off(D0, 3, 1)>(vb);
    asm volatile("s_waitcnt lgkmcnt(0)" ::: "memory"); SBAR();
#define PK(L, H) (bf16x8){L[0], L[1], L[2], L[3], H[0], H[1], H[2], H[3]}
    od = __builtin_amdgcn_mfma_f32_32x32x16_bf16(pa0, PK(l0, h0), od, 0, 0, 0);
    od = __builtin_amdgcn_mfma_f32_32x32x16_bf16(pa1, PK(l1, h1), od, 0, 0, 0);
    od = __builtin_amdgcn_mfma_f32_32x32x16_bf16(pa2, PK(l2, h2), od, 0, 0, 0);
    od = __builtin_amdgcn_mfma_f32_32x32x16_bf16(pa3, PK(l3, h3), od, 0, 0, 0);
#undef PK
}
__device__ __forceinline__ void pv_d0(f32x16* o, int vb, bf16x8 pa0, bf16x8 pa1, bf16x8 pa2, bf16x8 pa3) {
    pv_one<0>(o[0], vb, pa0, pa1, pa2, pa3); pv_one<1>(o[1], vb, pa0, pa1, pa2, pa3);
}
__device__ __forceinline__ int krow(int b, int T) { return T < 128 ? b * SEQ + 64 * T : MLAT + NCTX * b + 64 * (T - 128); }
__device__ __forceinline__ void attn_unit(const bf16* __restrict__ Qb, const bf16* __restrict__ Kh, const bf16* __restrict__ Vh, bf16* __restrict__ Ob, int b, int t_begin, int NT, char* lds, const int tid) {
    const int wid = tid >> 6, lane = tid & 63, r32 = lane & 31, hi = lane >> 5;
    char* V_lds = lds + LDS_V; char* K_lds = lds + LDS_K;
    float* ws = (float*)(lds + LDS_WS) + wid * 64; float* li_l = ws; float* al_l = ws + 32;
    float m_reg = -1e30f, l_reg = 0; f32x16 o[2] = {}; bf16x8 qr[6];
    const bf16* Qw = Qb + (long)(wid * QBLK + r32) * 768 + hi * 8;
#pragma unroll
    for (int d0 = 0; d0 < 6; ++d0) qr[d0] = *reinterpret_cast<const bf16x8*>(Qw + d0 * 16);
    const bool kst = wid < 6;
    const int sr = tid / 12, scK = (tid % 12) * 8, vr = tid >> 3, scV = (tid & 7) * 8;
    const int kw0 = KSWZ(sr, scK * 2), kw1 = KSWZ(32 + sr, scK * 2), vw = v_st(vr, scV);
    const int vb0 = (int)(uintptr_t)V_lds + v_rd_base(lane);
    struct { bf16x8 vs0, ks0, ks1; } sr_[2];
#define SLOAD(i, t) do { sr_[i].vs0 = *reinterpret_cast<const bf16x8*>(&Vh[((long)(t_begin + (t)) * 64 + vr) * 64 + scV]); \
    if (kst) { const long kt_ = (long)(t_begin + (t)) * 64; sr_[i].ks0 = *reinterpret_cast<const bf16x8*>(&Kh[(kt_ + sr) * 96 + scK]); sr_[i].ks1 = *reinterpret_cast<const bf16x8*>(&Kh[(kt_ + 32 + sr) * 96 + scK]); } } while (0)
#define SWRITE(bb, i) do { *(bf16x8*)(V_lds + (bb) * SHM_V + vw) = sr_[i].vs0; \
    if (kst) { *(bf16x8*)(K_lds + (bb) * SHM_K + kw0) = sr_[i].ks0; *(bf16x8*)(K_lds + (bb) * SHM_K + kw1) = sr_[i].ks1; } } while (0)
#define RESC(a) do { if (__any((a) < 1.f)) { if (hi == 0) al_l[r32] = (a); asm volatile("s_waitcnt lgkmcnt(0)" ::: "memory"); \
    _Pragma("unroll") for (int d = 0; d < 2; ++d) _Pragma("unroll") for (int r = 0; r < 16; ++r) o[d][r] *= al_l[crow(r, hi)]; } } while (0)
    f32x16 pA0, pA1, pB0, pB1; float mnA, mnB, alA, alB; bf16x8 pa0, pa1, pa2, pa3;
    constexpr int SE = 0, SO = 1;
    SLOAD(SE, 0); SWRITE(0, SE); __syncthreads();
    qkt(pA0, pA1, K_lds, qr, r32, hi); partialSM(pA0, pA1, m_reg, mnA, alA);
    SLOAD(SO, 1); if (2 < NT) SLOAD(SE, 2);
    SWRITE(1, SO); __syncthreads();
    for (int j = 1; j + 1 < NT; j += 2) {
        SBAR(); qkt(pB0, pB1, K_lds + SHM_K, qr, r32, hi);
        finishSM(pA0, pA1, alA, l_reg, pa0, pa1, pa2, pa3); SBAR();
        SLOAD(SO, j + 2); SBAR();
        pv_d0(o, vb0, pa0, pa1, pa2, pa3); partialSM(pB0, pB1, m_reg, mnB, alB);
        __syncthreads(); SWRITE(0, SE);
        RESC(alB); __syncthreads();
        SBAR(); qkt(pA0, pA1, K_lds, qr, r32, hi);
        finishSM(pB0, pB1, alB, l_reg, pa0, pa1, pa2, pa3); SBAR();
        if (j + 3 < NT) SLOAD(SE, j + 3); SBAR();
        pv_d0(o, vb0 + SHM_V, pa0, pa1, pa2, pa3); partialSM(pA0, pA1, m_reg, mnA, alA);
        __syncthreads(); SWRITE(1, SO);
        RESC(alA); __syncthreads();
    }
    SBAR(); qkt(pB0, pB1, K_lds + SHM_K, qr, r32, hi);
    finishSM(pA0, pA1, alA, l_reg, pa0, pa1, pa2, pa3); SBAR();
    pv_d0(o, vb0, pa0, pa1, pa2, pa3); partialSM(pB0, pB1, m_reg, mnB, alB);
    __syncthreads(); RESC(alB);
    finishSM(pB0, pB1, alB, l_reg, pa0, pa1, pa2, pa3); SBAR();
    pv_d0(o, vb0 + SHM_V, pa0, pa1, pa2, pa3);
    if (hi == 0) li_l[r32] = l_reg; asm volatile("s_waitcnt lgkmcnt(0)" ::: "memory");
    float rli[16];
#pragma unroll
    for (int r = 0; r < 16; ++r) rli[r] = __builtin_amdgcn_rcpf(li_l[crow(r, hi)]);
    bf16* Ow = Ob + (long)(wid * QBLK) * 512;
#pragma unroll
    for (int r = 0; r < 16; ++r) { const int orow = crow(r, hi);
#pragma unroll
        for (int d0 = 0; d0 < 2; ++d0) Ow[(long)orow * 512 + d0 * 32 + r32] = (bf16)(pk2(o[d0][r] * rli[r], 0.f) & 0xffffu); }
    __syncthreads();
#undef SLOAD
#undef SWRITE
#undef RESC
}

__device__ __forceinline__ s16x4 vtr(const LAS char* p) { typedef short v4i16_t __attribute__((ext_vector_type(4))); return __builtin_bit_cast(s16x4, __builtin_amdgcn_ds_read_tr16_b64_v4i16((LAS v4i16_t*)p)); }
__device__ __forceinline__ void qkt_fs(f32x16& p0, f32x16& p1, const LAS char* Ks, const bf16x8* qr, const f32x16& negb, int r32, int hi) {
#pragma unroll
    for (int d0 = 0; d0 < 6; ++d0) { const int cb = (d0 * 16 + hi * 8) * 2;
        const bf16x8 b0 = *(const LAS bf16x8*)(Ks + KSWZ(r32, cb));
        const bf16x8 b1 = *(const LAS bf16x8*)(Ks + KSWZ(32 + r32, cb));
        p0 = __builtin_amdgcn_mfma_f32_32x32x16_bf16(b0, qr[d0], d0 == 0 ? f32x16{} : p0, 0, 0, 0);
        p1 = __builtin_amdgcn_mfma_f32_32x32x16_bf16(b1, qr[d0], d0 == 0 ? f32x16{} : p1, 0, 0, 0); }
}
__device__ __forceinline__ void expack(f32x16& p0, f32x16& p1, bf16x8& pa0, bf16x8& pa1, bf16x8& pa2, bf16x8& pa3, float& l_reg) {
#pragma unroll
    for (int r = 0; r < 16; ++r) p0[r] = __builtin_amdgcn_exp2f(p0[r]);
#pragma unroll
    for (int r = 0; r < 16; ++r) p1[r] = __builtin_amdgcn_exp2f(p1[r]);
    { f32x2 s0 = {0.f, 0.f}, s1 = {0.f, 0.f};
#pragma unroll
      for (int r = 0; r < 16; r += 2) { s0 += (f32x2){p0[r], p0[r + 1]}; s1 += (f32x2){p1[r], p1[r + 1]}; }
      s0 += s1; l_reg += s0.x + s0.y; }
#define PK4(P, BASE, OUT) do { u32x4 w = {pk2(P[BASE + 0], P[BASE + 1]), pk2(P[BASE + 2], P[BASE + 3]), pk2(P[BASE + 4], P[BASE + 5]), pk2(P[BASE + 6], P[BASE + 7])}; OUT = __builtin_bit_cast(bf16x8, w); } while (0)
    PK4(p0, 0, pa0); PK4(p0, 8, pa1); PK4(p1, 0, pa2); PK4(p1, 8, pa3);
#undef PK4
}
__device__ __forceinline__ void pv3(f32x16* o, const LAS char* vp, bf16x8 pa0, bf16x8 pa1, bf16x8 pa2, bf16x8 pa3) {
#define PK(L, H) (bf16x8){L[0], L[1], L[2], L[3], H[0], H[1], H[2], H[3]}
#define PVK(ks, pa) do { const s16x4 l0 = vtr(vp + (ks) * 2048), h0 = vtr(vp + (ks) * 2048 + 256), l1 = vtr(vp + (ks) * 2048 + 512), h1 = vtr(vp + (ks) * 2048 + 512 + 256); \
    o[0] = __builtin_amdgcn_mfma_f32_32x32x16_bf16(pa, PK(l0, h0), o[0], 0, 0, 0); o[1] = __builtin_amdgcn_mfma_f32_32x32x16_bf16(pa, PK(l1, h1), o[1], 0, 0, 0); } while (0)
    PVK(0, pa0); PVK(1, pa1); PVK(2, pa2); PVK(3, pa3);
#undef PVK
#undef PK
}
__device__ __forceinline__ void attn_unit_fs(const bf16* __restrict__ Qb, const bf16* __restrict__ Kh, const bf16* __restrict__ Vh, bf16* __restrict__ Ob, int b, int t_begin, int NT, LAS char* lds, const int tid, const float bl2) {
    const int wid = tid >> 6, lane = tid & 63, r32 = lane & 31, hi = lane >> 5;
    LAS char* V_lds = lds + LDS_V; LAS char* K_lds = lds + LDS_K;
    f32x16 o[2] = {}; float l_reg = 0.f; bf16x8 qr[6]; const f32x16 negb = {};
    const bf16* Qw = Qb + (long)(wid * QBLK + r32) * 768 + hi * 8;
#pragma unroll
    for (int d0 = 0; d0 < 6; ++d0) qr[d0] = *reinterpret_cast<const bf16x8*>(Qw + d0 * 16);
    const bool kst = wid < 6;
    const int sr = tid / 12, scK = (tid % 12) * 8, vr = tid >> 3, scV = (tid & 7) * 8;
    const int kw0 = KSWZ(sr, scK * 2), kw1 = KSWZ(32 + sr, scK * 2), vw = v_st(vr, scV);
    const LAS char* vp0 = V_lds + (((lane & 3) << 3) | (((lane >> 2) & 3) << 6) | (((lane >> 4) & 1) << 5)) + hi * 1024;
    bf16x8 ks0, ks1, vs0;
    const unsigned kofB = (unsigned)(sr * 96 + scK) * 2u, vofB = (unsigned)(vr * 64 + scV) * 2u;
#define LDK(t) do { if (kst) { const int t_ = (t) < NT ? (t) : NT - 1; const char* kb_ = (const char*)Kh + (size_t)(t_begin + t_) * (64 * 192); \
    ks0 = *reinterpret_cast<const bf16x8*>(kb_ + kofB); ks1 = *reinterpret_cast<const bf16x8*>(kb_ + 32 * 192 + kofB); } } while (0)
#define LDV(t) do { const int t_ = (t) < NT ? (t) : NT - 1; const char* vb_ = (const char*)Vh + (size_t)(t_begin + t_) * (64 * 128); vs0 = *reinterpret_cast<const bf16x8*>(vb_ + vofB); } while (0)
#define WRK(bb) do { if (kst) { *(LAS bf16x8*)(K_lds + (bb) * SHM_K + kw0) = ks0; *(LAS bf16x8*)(K_lds + (bb) * SHM_K + kw1) = ks1; } } while (0)
#define WRV(bb) do { *(LAS bf16x8*)(V_lds + (bb) * SHM_V + vw) = vs0; } while (0)
    bf16x8 pa0, pa1, pa2, pa3;
    if (wid < 4) {
        f32x16 pA0, pA1, pB0, pB1;
        LDK(0); LDV(0); WRK(0); LDK(1); __syncthreads();
        qkt_fs(pA0, pA1, K_lds, qr, negb, r32, hi); WRK(1); WRV(0); LDK(2); LDV(1); __syncthreads();
        for (int j = 1; j + 1 < NT; j += 2) {
            qkt_fs(pB0, pB1, K_lds + SHM_K, qr, negb, r32, hi); expack(pA0, pA1, pa0, pa1, pa2, pa3, l_reg);
            pv3(o, vp0, pa0, pa1, pa2, pa3); WRK(0); WRV(1); LDK(j + 2); LDV(j + 1); __syncthreads();
            qkt_fs(pA0, pA1, K_lds, qr, negb, r32, hi); expack(pB0, pB1, pa0, pa1, pa2, pa3, l_reg);
            pv3(o, vp0 + SHM_V, pa0, pa1, pa2, pa3); WRK(1); WRV(0); LDK(j + 3); LDV(j + 2); __syncthreads();
        }
        qkt_fs(pB0, pB1, K_lds + SHM_K, qr, negb, r32, hi); expack(pA0, pA1, pa0, pa1, pa2, pa3, l_reg);
        pv3(o, vp0, pa0, pa1, pa2, pa3); WRV(1); __syncthreads();
        expack(pB0, pB1, pa0, pa1, pa2, pa3, l_reg);
        pv3(o, vp0 + SHM_V, pa0, pa1, pa2, pa3);
    } else {
        f32x16 p0, p1;
        LDK(0); LDV(0); WRK(0); LDK(1); __syncthreads();
        qkt_fs(p0, p1, K_lds, qr, negb, r32, hi); expack(p0, p1, pa0, pa1, pa2, pa3, l_reg); WRK(1); WRV(0); LDK(2); LDV(1); __syncthreads();
        for (int j = 1; j + 1 < NT; j += 2) {
            pv3(o, vp0, pa0, pa1, pa2, pa3);
            qkt_fs(p0, p1, K_lds + SHM_K, qr, negb, r32, hi); expack(p0, p1, pa0, pa1, pa2, pa3, l_reg);
            WRK(0); WRV(1); LDK(j + 2); LDV(j + 1); __syncthreads();
            pv3(o, vp0 + SHM_V, pa0, pa1, pa2, pa3);
            qkt_fs(p0, p1, K_lds, qr, negb, r32, hi); expack(p0, p1, pa0, pa1, pa2, pa3, l_reg);
            WRK(1); WRV(0); LDK(j + 3); LDV(j + 2); __syncthreads();
        }
        pv3(o, vp0, pa0, pa1, pa2, pa3);
        qkt_fs(p0, p1, K_lds + SHM_K, qr, negb, r32, hi); expack(p0, p1, pa0, pa1, pa2, pa3, l_reg);
        WRV(1); __syncthreads();
        pv3(o, vp0 + SHM_V, pa0, pa1, pa2, pa3);
    }
    { auto rr = __builtin_amdgcn_permlane32_swap(__float_as_uint(l_reg), __float_as_uint(l_reg), false, false); l_reg = __uint_as_float(rr[0]) + __uint_as_float(rr[1]); }
    LAS float* li_l = (LAS float*)(lds + LDS_WS) + wid * 64;
    if (hi == 0) li_l[r32] = l_reg;
    bf16* Ow = Ob + (long)(wid * QBLK) * 512;
#pragma unroll
    for (int r = 0; r < 16; ++r) { const int orow = crow(r, hi); const float rl = __builtin_amdgcn_rcpf(li_l[orow]);
#pragma unroll
        for (int d0 = 0; d0 < 2; ++d0) Ow[(long)orow * 512 + d0 * 32 + r32] = (bf16)(pk2(o[d0][r] * rl, 0.f) & 0xffffu); }
    __syncthreads();
#undef LDK
#undef LDV
#undef WRK
#undef WRV
}

typedef f32x4 acc4;
#define MF16(a_, b_, c_) __builtin_amdgcn_mfma_f32_16x16x32_bf16(a_, b_, c_, 0, 0, 0)
__device__ __forceinline__ void qkt16(acc4 (&s)[2][4], const LAS char* Ks, int kb0, int kb1, const bf16x8 (&qf)[2][3]) {
    const acc4 z4 = {0.f, 0.f, 0.f, 0.f};
#pragma unroll
    for (int ks = 0; ks < 3; ++ks)
#pragma unroll
        for (int kg = 0; kg < 4; ++kg) { const bf16x8 kf = *(const LAS bf16x8*)(Ks + ((ks & 1) ? kb1 : kb0) + kg * 4096 + (ks >> 1) * 128);
#pragma unroll
            for (int a = 0; a < 2; ++a) s[a][kg] = MF16(kf, qf[a][ks], ks == 0 ? z4 : s[a][kg]); }
}
__device__ __forceinline__ void expack16(acc4 (&s)[2][4], bf16x8 (&pa)[2][2], float (&l)[2]) {
#pragma unroll
    for (int a = 0; a < 2; ++a) { f32x2 t0 = {0.f, 0.f}, t1 = {0.f, 0.f};
#pragma unroll
        for (int kg = 0; kg < 4; ++kg) {
#pragma unroll
            for (int r = 0; r < 4; ++r) s[a][kg][r] = __builtin_amdgcn_exp2f(s[a][kg][r]);
            t0 += (f32x2){s[a][kg][0], s[a][kg][1]}; t1 += (f32x2){s[a][kg][2], s[a][kg][3]}; }
        t0 += t1; l[a] += t0.x + t0.y;
#pragma unroll
        for (int kb = 0; kb < 2; ++kb) { const acc4 u = s[a][2 * kb], v = s[a][2 * kb + 1];
            u32x4 w = {pk2(u[0], u[1]), pk2(u[2], u[3]), pk2(v[0], v[1]), pk2(v[2], v[3])}; pa[a][kb] = __builtin_bit_cast(bf16x8, w); } }
}
__device__ __forceinline__ void pv16(acc4 (&o)[4][2], const LAS char* vp, const bf16x8 (&pa)[2][2]) {
#pragma unroll
    for (int kb = 0; kb < 2; ++kb)
#pragma unroll
        for (int dg = 0; dg < 4; ++dg) { const LAS char* p = vp + kb * 4096 + (dg >> 1) * 512 + (dg & 1) * 32;
            const s16x4 lo = vtr(p), hi = vtr(p + 2048); const bf16x8 vf = {lo[0], lo[1], lo[2], lo[3], hi[0], hi[1], hi[2], hi[3]};
#pragma unroll
            for (int a = 0; a < 2; ++a) o[dg][a] = MF16(vf, pa[a][kb], o[dg][a]); }
}
__device__ __forceinline__ void pv16_pre(bf16x8 (&vfp)[4], const LAS char* vp) {
#pragma unroll
    for (int dg = 0; dg < 4; ++dg) { const LAS char* p = vp + (dg >> 1) * 512 + (dg & 1) * 32; const s16x4 lo = vtr(p), hi = vtr(p + 2048);
        vfp[dg] = (bf16x8){lo[0], lo[1], lo[2], lo[3], hi[0], hi[1], hi[2], hi[3]}; }
}
__device__ __forceinline__ void pv16_post(acc4 (&o)[4][2], const LAS char* vp, const bf16x8 (&pa)[2][2], const bf16x8 (&vfp)[4]) {
#pragma unroll
    for (int dg = 0; dg < 4; ++dg)
#pragma unroll
        for (int a = 0; a < 2; ++a) o[dg][a] = MF16(vfp[dg], pa[a][0], o[dg][a]);
#pragma unroll
    for (int dg = 0; dg < 4; ++dg) { const LAS char* p = vp + 4096 + (dg >> 1) * 512 + (dg & 1) * 32;
        const s16x4 lo = vtr(p), hi = vtr(p + 2048); const bf16x8 vf = {lo[0], lo[1], lo[2], lo[3], hi[0], hi[1], hi[2], hi[3]};
#pragma unroll
        for (int a = 0; a < 2; ++a) o[dg][a] = MF16(vf, pa[a][1], o[dg][a]); }
}
__device__ __forceinline__ void attn_unit_m16(const bf16* __restrict__ Qb, const bf16* __restrict__ Kh, const bf16* __restrict__ Vh, bf16* __restrict__ Ob, int t_begin, int NT, LAS char* lds, const int tid) {
    const int wid = tid >> 6, lane = tid & 63, g = lane >> 4, j = lane & 15;
    LAS char* V_lds = lds; LAS char* K_lds = lds + 3 * SHM_V;
    acc4 o[4][2]; float l[2] = {0.f, 0.f}; bf16x8 qf[2][3];
#pragma unroll
    for (int dg = 0; dg < 4; ++dg)
#pragma unroll
        for (int a = 0; a < 2; ++a) o[dg][a] = (acc4){0.f, 0.f, 0.f, 0.f};
#pragma unroll
    for (int a = 0; a < 2; ++a)
#pragma unroll
        for (int ks = 0; ks < 3; ++ks) qf[a][ks] = *reinterpret_cast<const bf16x8*>(Qb + (long)(wid * QBLK + 16 * a + j) * 768 + 32 * ks + 8 * g);
    const int tl = tid & 255, idH0 = tl, idH1 = tl + 256, idL = tl + 512;
    const int vr = tid >> 3, scV = (tid & 7) * 8;
    const int kwH0 = KSWZ(idH0 / 12, (idH0 % 12) * 16), kwH1 = KSWZ(idH1 / 12, (idH1 % 12) * 16), kwL = KSWZ(idL / 12, (idL % 12) * 16), vw = v_st(vr, scV);
    const int kb0 = j * 256 + ((g ^ (j & 7)) * 16), kb1 = j * 256 + (((4 | g) ^ (j & 7)) * 16);
    const LAS char* vp0 = V_lds + (g & 1) * 1024 + ((((lane >> 2) & 3) + 4 * (g >> 1)) * 64) + (lane & 3) * 8;
    bf16x8 ks0, ks1, vs0;
    const unsigned kofH0 = (unsigned)idH0 * 16u, kofH1 = (unsigned)idH1 * 16u, kofL = (unsigned)idL * 16u, vofB = (unsigned)(vr * 64 + scV) * 2u;
#define LDK(t, P) do { const int t_ = (t) < NT ? (t) : NT - 1; const char* kb_ = (const char*)Kh + (size_t)(t_begin + t_) * (64 * 192); \
    if (HALF == (P)) { ks0 = *reinterpret_cast<const bf16x8*>(kb_ + kofH0); ks1 = *reinterpret_cast<const bf16x8*>(kb_ + kofH1); } else ks0 = *reinterpret_cast<const bf16x8*>(kb_ + kofL); } while (0)
#define LDV(t) do { const int t_ = (t) < NT ? (t) : NT - 1; const char* vb_ = (const char*)Vh + (size_t)(t_begin + t_) * (64 * 128); vs0 = *reinterpret_cast<const bf16x8*>(vb_ + vofB); } while (0)
#define WRK(bb) do { if (HALF == (bb)) { *(LAS bf16x8*)(K_lds + (bb) * SHM_K + kwH0) = ks0; *(LAS bf16x8*)(K_lds + (bb) * SHM_K + kwH1) = ks1; } else *(LAS bf16x8*)(K_lds + (bb) * SHM_K + kwL) = ks0; } while (0)
#define WRV(off) do { *(LAS bf16x8*)(V_lds + (off) + vw) = vs0; } while (0)
#define VROT() do { vprev = vcur; vcur = (vcur == 2 * SHM_V) ? 0 : vcur + SHM_V; } while (0)
#define A_BODY() do { acc4 pA[2][4], pB[2][4]; bf16x8 vfp[4]; int vcur = 0, vprev = 0; \
        LDK(0, 0); LDV(0); WRK(0); LDK(1, 1); __syncthreads(); \
        qkt16(pA, K_lds, kb0, kb1, qf); WRK(1); WRV(vcur); LDK(2, 0); LDV(1); __syncthreads(); VROT(); \
        for (int jt = 1; jt + 1 < NT; jt += 2) { \
            qkt16(pB, K_lds + SHM_K, kb0, kb1, qf); WRK(0); WRV(vcur); LDK(jt + 2, 1); LDV(jt + 1); expack16(pA, pa, l); pv16_pre(vfp, vp0 + vprev); __syncthreads(); \
            pv16_post(o, vp0 + vprev, pa, vfp); VROT(); \
            qkt16(pA, K_lds, kb0, kb1, qf); WRK(1); WRV(vcur); LDK(jt + 3, 0); LDV(jt + 2); expack16(pB, pa, l); pv16_pre(vfp, vp0 + vprev); __syncthreads(); \
            pv16_post(o, vp0 + vprev, pa, vfp); VROT(); \
        } \
        qkt16(pB, K_lds + SHM_K, kb0, kb1, qf); WRV(vcur); expack16(pA, pa, l); __syncthreads(); \
        pv16(o, vp0 + vprev, pa); VROT(); \
        expack16(pB, pa, l); \
        pv16(o, vp0 + vprev, pa); } while (0)
    bf16x8 pa[2][2];
    if (wid < 4) { constexpr int HALF = 0; A_BODY(); }
    else { constexpr int HALF = 1; A_BODY(); }
#pragma unroll
    for (int a = 0; a < 2; ++a) { float t = l[a]; t += __shfl_xor(t, 16); t += __shfl_xor(t, 32); const float rl = __builtin_amdgcn_rcpf(t);
        bf16* orow = Ob + (long)(wid * QBLK + 16 * a + j) * 512 + 4 * g;
#pragma unroll
        for (int dg = 0; dg < 4; ++dg) { u32x2 w = {pk2(o[dg][a][0] * rl, o[dg][a][1] * rl), pk2(o[dg][a][2] * rl, o[dg][a][3] * rl)}; *(u32x2*)(orow + 16 * dg) = w; } }
    __syncthreads();
#undef LDK
#undef LDV
#undef WRK
#undef WRV
#undef VROT
#undef A_BODY
}
#undef MF16
#undef SBAR
}

#define XB_TMO      128
#define XB_XCNT(j)  (256  + 64 * (j))
#define XB_XSUB(j)  (1280 + 64 * (j))
#define XB_XGEN(j)  (2304 + 64 * (j))
#define XB_TOP      3328
#define XB_TOPGEN   3392
#define XCD_BAR_WORDS 3456
#define XB_SPIN_CAP (1u << 18)
__device__ __forceinline__ unsigned xb_ld(unsigned* p)              { return __hip_atomic_load(p, __ATOMIC_RELAXED, __HIP_MEMORY_SCOPE_AGENT); }
__device__ __forceinline__ unsigned xb_add(unsigned* p, unsigned v) { return __hip_atomic_fetch_add(p, v, __ATOMIC_RELAXED, __HIP_MEMORY_SCOPE_AGENT); }
__device__ __forceinline__ unsigned xb_xcc_id() { return (unsigned)__builtin_amdgcn_s_getreg((3 << 11) | 20) & 0xFu; }
#define XB_SPIN(cond, bar) do { unsigned _sp = 0; while (cond) { __builtin_amdgcn_s_sleep(1); \
    if ((++_sp & 255u) == 0u) { if (xb_ld(&(bar)[XB_TMO])) break; if (_sp > XB_SPIN_CAP) { atomicAdd(&(bar)[XB_TMO], 1u); break; } } } } while (0)
struct XcdBarrier { unsigned* bar; unsigned x; volatile LAS unsigned* st; };
__device__ __forceinline__ void xcd_barrier_complete(unsigned* bar, unsigned x, unsigned& nloc, unsigned& nx) {
    const unsigned G = gridDim.x * gridDim.y * gridDim.z;
    unsigned sum, cnt, mine, sp = 0u;
    for (;;) {
        sum = 0u; cnt = 0u; mine = 0u;
#pragma unroll
        for (unsigned j = 0; j < 16; ++j) { const unsigned c = xb_ld(&bar[XB_XCNT(j)]); sum += c; cnt += (c > 0u) ? 1u : 0u; mine = (j == x) ? c : mine; }
        if (sum == G) break;
        __builtin_amdgcn_s_sleep(1);
        if ((++sp & 255u) == 0u) { if (xb_ld(&bar[XB_TMO])) break; if (sp > XB_SPIN_CAP) { atomicAdd(&bar[XB_TMO], 1u); break; } }
    }
    nloc = mine > 0u ? mine : 1u; nx = cnt > 0u ? cnt : 1u;
}
__device__ __forceinline__ void xcd_barrier(const XcdBarrier& b) {
    asm volatile("s_waitcnt vmcnt(0)" ::: "memory");
    __syncthreads();
    if (threadIdx.x == 0) {
        unsigned* bar = b.bar;
        __builtin_amdgcn_s_waitcnt(0);
        unsigned nloc = b.st[0], nx = b.st[1];
        if (nloc == 0u) { xcd_barrier_complete(bar, b.x, nloc, nx); b.st[0] = nloc; b.st[1] = nx; }
        const unsigned old = xb_add(&bar[XB_XSUB(b.x)], 1u);
        const unsigned gen = old / nloc;
        if (old + 1u == (gen + 1u) * nloc) {
            __builtin_amdgcn_fence(__ATOMIC_RELEASE, "agent");
            asm volatile("s_waitcnt vmcnt(0)" ::: "memory");
            const unsigned og = xb_add(&bar[XB_TOP], 1u);
            const unsigned tg = og / nx;
            if (og + 1u == (tg + 1u) * nx) xb_add(&bar[XB_TOPGEN], 1u);
            else XB_SPIN(xb_ld(&bar[XB_TOPGEN]) == tg, bar);
            __builtin_amdgcn_fence(__ATOMIC_ACQUIRE, "agent");
            xb_add(&bar[XB_XGEN(b.x)], 1u);
            asm volatile("s_waitcnt vmcnt(0)" ::: "memory");
        } else {
            XB_SPIN(xb_ld(&bar[XB_XGEN(b.x)]) == gen, bar);
            __builtin_amdgcn_fence(__ATOMIC_ACQUIRE, "agent");
            asm volatile("s_waitcnt vmcnt(0)" ::: "memory");
        }
    }
    __syncthreads();
}

constexpr int LDS_BYTES = 147456;
constexpr int NPH_LAYER = 13 + (REPK >= 0 ? 1 : 0), NPHASES = 1 + 2 * NPH_LAYER;
struct Args { const float* in[26]; float* out; unsigned char* ws; int ph_lo, ph_hi; };

__device__ __forceinline__ void transpose_item(const float* W, int K, int Nsrc, bf16* WT, int Ndst, int mode, const float* rowscale, LAS float* scr, int item, int lane) {
    const int nblk = Ndst / 32, kb = item / nblk, nb = item % nblk, k0 = 64 * kb, n0 = 32 * nb;
    int src = n0; bool zero = false;
    if (mode == 1) src = ((n0 >> 7) & 1) * DFF + (n0 >> 8) * 128 + (n0 & 127); else zero = n0 >= Nsrc;
    f32x4 v[8];
#pragma unroll
    for (int i = 0; i < 8; ++i) { const int kk = 8 * i + (lane >> 3);
        v[i] = zero ? (f32x4){0.f, 0.f, 0.f, 0.f} : *(const f32x4*)(W + (size_t)(k0 + kk) * Nsrc + src + 4 * (lane & 7));
        if (rowscale) v[i] = v[i] * rowscale[k0 + kk]; }
#pragma unroll
    for (int i = 0; i < 8; ++i) { const int kk = 8 * i + (lane >> 3); LAS float* d = scr + kk * 33 + 4 * (lane & 7); d[0] = v[i].x; d[1] = v[i].y; d[2] = v[i].z; d[3] = v[i].w; }
    asm volatile("s_waitcnt lgkmcnt(0)" ::: "memory");
    const int c = lane & 7;
#pragma unroll
    for (int j = 0; j < 4; ++j) { const int n = (lane >> 3) + 8 * j; const LAS float* s = scr + (8 * c) * 33 + n;
        u32x4 o; o.x = pk2(s[0 * 33], s[1 * 33]); o.y = pk2(s[2 * 33], s[3 * 33]); o.z = pk2(s[4 * 33], s[5 * 33]); o.w = pk2(s[6 * 33], s[7 * 33]);
        *(u32x4*)(WT + (size_t)(n0 + n) * K + k0 + 8 * c) = o; }
    asm volatile("s_waitcnt lgkmcnt(0)" ::: "memory");
}
__device__ __forceinline__ void sincos_d(double x, double& s, double& c) {
    const double k = __builtin_rint(x * 0.6366197723675814);
    double r = __builtin_fma(-k, 1.5707963267948966, x); r = __builtin_fma(-k, 6.123233995736766e-17, r);
    const double r2 = r * r;
    double sp = 1.0 / 6227020800.0; sp = sp * r2 - 1.0 / 39916800.0; sp = sp * r2 + 1.0 / 362880.0; sp = sp * r2 - 1.0 / 5040.0; sp = sp * r2 + 1.0 / 120.0; sp = sp * r2 - 1.0 / 6.0; sp = sp * r2 + 1.0; sp *= r;
    double cp = -1.0 / 87178291200.0; cp = cp * r2 + 1.0 / 479001600.0; cp = cp * r2 - 1.0 / 3628800.0; cp = cp * r2 + 1.0 / 40320.0; cp = cp * r2 - 1.0 / 720.0; cp = cp * r2 + 1.0 / 24.0; cp = cp * r2 - 0.5; cp = cp * r2 + 1.0;
    const int n = ((int)k) & 3;
    s = (n == 0) ? sp : (n == 1) ? cp : (n == 2) ? -sp : -cp;
    c = (n == 0) ? cp : (n == 1) ? -sp : (n == 2) ? -cp : sp;
}

__global__ void __launch_bounds__(512, 2) mk_fwd(Args args) {
    extern __shared__ __attribute__((aligned(16))) unsigned char lds_raw[];
    LAS unsigned char* lds = (LAS unsigned char*)lds_raw;
    cg::grid_group grid = cg::this_grid();
    const int ph_lo = args.ph_lo, ph_hi = args.ph_hi;
    volatile LAS unsigned* MISC = (volatile LAS unsigned*)(lds + 131072 + 64);
    if (threadIdx.x < 4) MISC[threadIdx.x] = 0u;
    __syncthreads();
    if (!MK_MULTI && threadIdx.x == 0) (void)xb_add(&((unsigned*)(args.ws + WS_CTL))[XB_XCNT(xb_xcc_id())], 1u);
    if (!MK_MULTI && ph_hi > 1) grid.sync();
    typedef const float* __attribute__((address_space(4))) const* in_tab_t;

    if (ph_lo == 0 && PHEN(0)) {
        int tid = threadIdx.x; asm volatile("" : "+v"(tid));
        int bx = blockIdx.x; asm volatile("" : "+s"(bx));
        const unsigned char __attribute__((address_space(4)))* kp = (const unsigned char __attribute__((address_space(4)))*)__builtin_amdgcn_kernarg_segment_ptr(); asm volatile("" : "+s"(kp));
        struct InTab { in_tab_t p; __device__ __forceinline__ const float* operator[](int i) const { return p[i]; } };
        struct ArgsV { InTab in; } args_v; args_v.in.p = (in_tab_t)kp;
#define args args_v
        float* out = *(float* const __attribute__((address_space(4)))*)(kp + 26 * 8);
        unsigned char* ws = *(unsigned char* const __attribute__((address_space(4)))*)(kp + 27 * 8);
        const int lane = tid & 63, wave = __builtin_amdgcn_readfirstlane(tid >> 6);
        const int G = gridDim.x, gw = bx * 8 + wave, NGW = G * 8;
        float* mod = (float*)(ws + WS_MOD); float* rope = (float*)(ws + WS_ROPE);
        float* HC = (float*)(ws + WS_HC); bf16* Abuf = (bf16*)(ws + WS_A);
        bf16* U = (bf16*)(ws + WS_R + R_U); bf16* MIX = (bf16*)(ws + WS_R + R_MIX); bf16* Obuf = (bf16*)(ws + WS_R + R_O);
        bf16* QRAW = (bf16*)(ws + WS_R + R_QRAW); bf16* KVRAW = (bf16*)(ws + WS_R + R_KVRAW); bf16* Kbuf = (bf16*)(ws + WS_R + R_K); bf16* Vbuf = (bf16*)(ws + WS_R + R_V);
        const float* x_in = args.in[0]; const float* ctx_in = args.in[2]; float* PART = (float*)(ws + WS_R + 200 * MiB);
            LAS float* scv = (LAS float*)lds;
            LAS float* red = (LAS float*)(lds + 20480);
            for (int i = tid; i < 5 * DM; i += 512) { const int s = i >> 10, k = i & 1023; const float v = s < 4 ? args.in[1][s * DM + k] : args.in[3][k]; scv[i] = fsilu(v); }
            __syncthreads();
            for (int chunk = bx; chunk < 288; chunk += G) {
                const int l = chunk / 144, n0 = (chunk % 144) * 64, kq = tid >> 4, cq = tid & 15;
                const float* wa = args.in[4] + (size_t)l * DM * ADA + n0 + 4 * cq;
                f32x4 acc[5];
#pragma unroll
                for (int s = 0; s < 5; ++s) acc[s] = (f32x4){0.f, 0.f, 0.f, 0.f};
#pragma unroll 4
                for (int i = 0; i < 32; ++i) { const int k = kq + 32 * i; const f32x4 w = *(const f32x4*)(wa + (size_t)k * ADA);
#pragma unroll
                    for (int s = 0; s < 5; ++s) acc[s] += w * scv[s * DM + k]; }
#pragma unroll
                for (int s = 0; s < 5; ++s)
#pragma unroll
                    for (int e = 0; e < 4; ++e) red[(kq * 5 + s) * 64 + 4 * cq + e] = acc[s][e];
                __syncthreads();
                if (tid < 320) { const int s = tid >> 6, col = tid & 63; float v = 0.f;
                    for (int q = 0; q < 32; ++q) v += red[(q * 5 + s) * 64 + col];
                    mod[(size_t)(l * 5 + s) * ADA + n0 + col] = v + args.in[5][l * ADA + n0 + col]; }
                __syncthreads();
            }
            { const int gt = bx * 512 + tid;
              if (gt < 1024) { const int pos = gt >> 3, j = gt & 7; const int e = j >> 1;
                  double base = (j & 1) ? 0.31622776601683794 : 1.0; base *= (e == 0 ? 1.0 : e == 1 ? 0.1 : e == 2 ? 0.01 : 0.001);
                  const float invf = (float)base; const float ang = (float)pos * invf; double s, c; sincos_d((double)ang, s, c);
                  rope[2 * gt] = (float)c; rope[2 * gt + 1] = (float)s; } }
            __syncthreads();
            for (int i = bx * 512 + tid; i < MCTX * DM / 4; i += G * 512) ((f32x4*)HC)[i] = ((const f32x4*)ctx_in)[i];
            LAS float* scr = (LAS float*)(lds + wave * 16384);
            constexpr int I_IN = 16 * 176, I_OUT = 44 * 32, I_MIX = 16 * 64, I_Q = 6 * 24, I_KV = 4 * 32, I_MO = 16 * 32;
            constexpr int I_LAYER = 2 * I_IN + 2 * I_OUT + I_MIX + I_Q + I_KV + I_MO;
            for (int it = gw; it < 2 * I_LAYER; it += NGW) {
                const int l = it / I_LAYER; int r = it % I_LAYER; unsigned char* wl = ws + WS_W + (size_t)l * W_LAYER;
                if (r < I_IN) { transpose_item(args.in[7] + (size_t)l * DM * 2 * DFF, DM, 2 * DFF, (bf16*)(wl + WO_FFN1IN), 2 * DFF, 1, nullptr, scr, r, lane); continue; } r -= I_IN;
                if (r < I_OUT) { transpose_item(args.in[8] + (size_t)l * DFF * DM, DFF, DM, (bf16*)(wl + WO_FFN1OUT), DM, 0, nullptr, scr, r, lane); continue; } r -= I_OUT;
                if (r < I_MIX) { transpose_item(args.in[10] + (size_t)l * DM * MIXN, DM, MIXN, (bf16*)(wl + WO_MIXIN), MIXP, 0, nullptr, scr, r, lane); continue; } r -= I_MIX;
                if (r < I_Q) { transpose_item(args.in[12] + (size_t)l * QLORA * 768, QLORA, 768, (bf16*)(wl + WO_QUP), 768, 0, args.in[11] + l * QLORA, scr, r, lane); continue; } r -= I_Q;
                if (r < I_KV) { transpose_item(args.in[14] + (size_t)l * KVLORA * 1024, KVLORA, 1024, (bf16*)(wl + WO_KVUP), 1024, 0, args.in[13] + l * KVLORA, scr, r, lane); continue; } r -= I_KV;
                if (r < I_MO) { transpose_item(args.in[22] + (size_t)l * DM * DM, DM, DM, (bf16*)(wl + WO_MIXOUT), DM, 0, nullptr, scr, r, lane); continue; } r -= I_MO;
                if (r < I_IN) { transpose_item(args.in[24] + (size_t)l * DM * 2 * DFF, DM, 2 * DFF, (bf16*)(wl + WO_FFN2IN), 2 * DFF, 1, nullptr, scr, r, lane); continue; } r -= I_IN;
                transpose_item(args.in[25] + (size_t)l * DFF * DM, DFF, DM, (bf16*)(wl + WO_FFN2OUT), DM, 0, nullptr, scr, r, lane);
            }
#undef args
        if (ph_hi > 1) { XcdBarrier xb; xb.bar = (unsigned*)(args.ws + WS_CTL); xb.x = xb_xcc_id(); xb.st = MISC; xcd_barrier(xb); }
    }
    for (int ph = (ph_lo < 1 ? 1 : ph_lo); ph < ph_hi; ++ph) {
        int tid = threadIdx.x; asm volatile("" : "+v"(tid));
        int bx = blockIdx.x; asm volatile("" : "+s"(bx));
        const unsigned char __attribute__((address_space(4)))* kp = (const unsigned char __attribute__((address_space(4)))*)__builtin_amdgcn_kernarg_segment_ptr(); asm volatile("" : "+s"(kp));
        struct InTab { in_tab_t p; __device__ __forceinline__ const float* operator[](int i) const { return p[i]; } };
        struct ArgsV { InTab in; } args_v; args_v.in.p = (in_tab_t)kp;
#define args args_v
        float* out = *(float* const __attribute__((address_space(4)))*)(kp + 26 * 8);
        unsigned char* ws = *(unsigned char* const __attribute__((address_space(4)))*)(kp + 27 * 8);
        const int lane = tid & 63, wave = __builtin_amdgcn_readfirstlane(tid >> 6);
        const int G = gridDim.x, gw = bx * 8 + wave, NGW = G * 8;
        float* mod = (float*)(ws + WS_MOD); float* rope = (float*)(ws + WS_ROPE);
        float* HC = (float*)(ws + WS_HC); bf16* Abuf = (bf16*)(ws + WS_A);
        bf16* U = (bf16*)(ws + WS_R + R_U); bf16* MIX = (bf16*)(ws + WS_R + R_MIX); bf16* Obuf = (bf16*)(ws + WS_R + R_O);
        bf16* QRAW = (bf16*)(ws + WS_R + R_QRAW); bf16* KVRAW = (bf16*)(ws + WS_R + R_KVRAW); bf16* Kbuf = (bf16*)(ws + WS_R + R_K); bf16* Vbuf = (bf16*)(ws + WS_R + R_V);
        const float* x_in = args.in[0]; const float* ctx_in = args.in[2]; float* PART = (float*)(ws + WS_R + 200 * MiB);
        {
            const int l = (ph - 1) / NPH_LAYER, slot = (ph - 1) % NPH_LAYER, k = (REPK >= 0 && slot > REPK) ? slot - 1 : slot; const bool last = (l == 1);
            unsigned char* wl = ws + WS_W + (size_t)l * W_LAYER; const float* modl = mod + (size_t)l * 5 * ADA;
            const float* h_lat = (l == 0 && k <= 2) ? x_in : out; const float* h_ctx = HC;
            if ((k == 0 || k == 3 || k == 10) && PHEN(1)) {
                const int ch = (k == 0) ? 0 : (k == 3) ? 3 : 6; const float* g = (k == 0 ? args.in[6] : k == 3 ? args.in[9] : args.in[23]) + l * DM;
                const int nrows = (k == 10 && last) ? MLAT : MTOT;
                const int nsp = (k == 0) ? (l == 1 ? 11 : 0) : (k == 3) ? 11 : (last ? 0 : 4);
#pragma unroll 2
                for (int row = gw; row < nrows; row += NGW) {
                    const bool lat = row < MLAT; const float* src = lat ? h_lat + (size_t)row * DM : h_ctx + (size_t)(row - MLAT) * DM; const int s = lat ? (row >> 13) : 4;
                    const float* sh = modl + (size_t)s * ADA + ch * DM; const float* sc = sh + DM;
                    f32x4 v[4]; float ss = 0.f;
#pragma unroll
                    for (int j = 0; j < 4; ++j) v[j] = *(const f32x4*)(src + 4 * lane + 256 * j);
                    if (!lat && nsp) {
                        for (int sp = 0; sp < nsp; ++sp) { const float* pr = PART + (size_t)sp * ((size_t)MCTX * DM) + (size_t)(row - MLAT) * DM + 4 * lane;
#pragma unroll
                            for (int j = 0; j < 4; ++j) v[j] += *(const f32x4*)(pr + 256 * j); }
#pragma unroll
                        for (int j = 0; j < 4; ++j) *(f32x4*)(HC + (size_t)(row - MLAT) * DM + 4 * lane + 256 * j) = v[j];
                    }
#pragma unroll
                    for (int j = 0; j < 4; ++j) ss += (v[j].x * v[j].x + v[j].y * v[j].y) + (v[j].z * v[j].z + v[j].w * v[j].w);
                    const float rstd = __builtin_amdgcn_rsqf(wave_sum(ss) * (1.f / DM) + EPS);
#pragma unroll
                    for (int j = 0; j < 4; ++j) { const int c = 4 * lane + 256 * j; const f32x4 gg = *(const f32x4*)(g + c), s1 = *(const f32x4*)(sc + c), s0 = *(const f32x4*)(sh + c);
                        const f32x4 o = v[j] * rstd * gg * (s1 + 1.f) + s0; u32x2 w; w.x = pk2(o.x, o.y); w.y = pk2(o.z, o.w); *(u32x2*)(Abuf + (size_t)row * DM + c) = w; }
                }
            } else if ((k == 1 || k == 11) && PHEN(2)) {
                pg8::Gemm g{Abuf, (const bf16*)(wl + (k == 1 ? WO_FFN1IN : WO_FFN2IN)), (k == 11 && last) ? MLAT : MTOT, 2 * DFF, DM, DM};
                pg8::StaticOrder S; S.init(g.M, g.N, g.K, G, bx); pg8::EpiSwiGLU E{U, DFF};
                pg8::gemm_phase<pg8::EpiSwiGLU>(lds, g, S, E, tid);
            } else if ((k == 2 || k == 9 || k == 12) && PHEN(3)) {
                const bf16* Bt = (const bf16*)(wl + (k == 2 ? WO_FFN1OUT : k == 9 ? WO_MIXOUT : WO_FFN2OUT));
                pg8::Gemm g{k == 9 ? Abuf : U, Bt, (k != 2 && last) ? MLAT : MTOT, DM, k == 9 ? DM : DFF, k == 9 ? DM : DFF};
                pg8::StaticOrder S; S.init(g.M, g.N, g.K, G, bx, g.M - MLAT, 4);
                pg8::EpiResid E{h_lat, HC, out, HC, modl + (k == 2 ? 2 : k == 9 ? 5 : 8) * DM, k == 9 ? 1.f : 0.5f, g.K / pg8::BK, PART};
                pg8::gemm_phase<pg8::EpiResid>(lds, g, S, E, tid);
            } else if (k == 4 && PHEN(4)) {
                pg8::Gemm g{Abuf, (const bf16*)(wl + WO_MIXIN), MTOT, MIXP, DM, DM};
                pg8::StaticOrder S; S.init(g.M, g.N, g.K, G, bx); pg8::EpiStore E{MIX, MIXP};
                pg8::gemm_phase<pg8::EpiStore>(lds, g, S, E, tid);
            } else if (k == 5 && PHEN(5)) {
                { pg8::Gemm g{MIX, (const bf16*)(wl + WO_QUP), last ? MLAT : MTOT, 768, QLORA, MIXP};
                  pg8::StaticOrder S; S.init(g.M, g.N, g.K, G, bx); pg8::EpiStore E{QRAW, 768};
                  pg8::gemm_phase<pg8::EpiStore>(lds, g, S, E, tid); }
                { pg8::Gemm g{MIX + OFF_KV, (const bf16*)(wl + WO_KVUP), MTOT, 1024, KVLORA, MIXP};
                  pg8::StaticOrder S; S.init(g.M, g.N, g.K, G, (bx + 116) % G); pg8::EpiStore E{KVRAW, 1024};
                  pg8::gemm_phase<pg8::EpiStore>(lds, g, S, E, tid); }
            } else if (k == 6 && PHEN(6)) {
                const float* g_out = args.in[21] + l * DM;
                const int nchunk = last ? MLAT / 128 : MTOT / 128;
                LAS bf16* vT = (LAS bf16*)lds;
                for (int ci = bx; ci < nchunk; ci += G) {
                    { const int q = tid >> 2, gI = tid & 3; const bf16* src = MIX + (size_t)(ci * 128 + q) * MIXP + OFF_SG + 256 + gI * 64;
                      float vv[64]; float ss = 0.f;
#pragma unroll
                      for (int i = 0; i < 8; ++i) { const u32x4 w = *(const u32x4*)(src + 8 * i);
#pragma unroll
                          for (int e = 0; e < 4; ++e) { const float a = fgelu(bflo(w[e])), b2 = fgelu(bfhi(w[e])); vv[8 * i + 2 * e] = a; vv[8 * i + 2 * e + 1] = b2; ss += a * a + b2 * b2; } }
                      const float rs = __builtin_amdgcn_rsqf(ss * (1.f / 64.f) + EPS); const float* gs = args.in[17] + l * 256 + gI * 64;
#pragma unroll
                      for (int c = 0; c < 64; ++c) vT[(gI * 64 + c) * 136 + q] = (bf16)(pk2(vv[c] * rs * gs[c], 0.f) & 0xffffu); }
                    __syncthreads();
                    { const int fr = lane & 15, fq = lane >> 4, p0 = 16 * wave;
                      float ssr[4] = {0.f, 0.f, 0.f, 0.f};
                      f32x4 acc[4][4];
#pragma unroll
                      for (int gI = 0; gI < 4; ++gI) {
#pragma unroll
                          for (int nt = 0; nt < 4; ++nt) acc[gI][nt] = (f32x4){0.f, 0.f, 0.f, 0.f};
                          const float* wsp = args.in[18] + ((size_t)(l * 4 + gI) * 128 + p0 + fr) * 128 + 8 * fq;
#pragma unroll
                          for (int ks = 0; ks < 4; ++ks) { const f32x4 w0 = *(const f32x4*)(wsp + 32 * ks), w1 = *(const f32x4*)(wsp + 32 * ks + 4);
                              u32x4 aw = {pk2(w0[0], w0[1]), pk2(w0[2], w0[3]), pk2(w1[0], w1[1]), pk2(w1[2], w1[3])}; const bf16x8 af = __builtin_bit_cast(bf16x8, aw);
#pragma unroll
                              for (int nt = 0; nt < 4; ++nt) { const bf16x8 bfr = *(const LAS bf16x8*)(vT + (gI * 64 + 16 * nt + fr) * 136 + 32 * ks + 8 * fq);
                                  acc[gI][nt] = __builtin_amdgcn_mfma_f32_16x16x32_bf16(af, bfr, acc[gI][nt], 0, 0, 0); } }
#pragma unroll
                          for (int r = 0; r < 4; ++r) { const int p = p0 + 4 * fq + r; const float bias = args.in[19][(l * 4 + gI) * 128 + p]; const bf16* up = MIX + (size_t)(ci * 128 + p) * MIXP + OFF_SG + gI * 64;
#pragma unroll
                              for (int nt = 0; nt < 4; ++nt) { const float uu = fgelu(bf1(up[16 * nt + fr])); const float ov = uu * (acc[gI][nt][r] + bias); acc[gI][nt][r] = ov; ssr[r] += ov * ov; } }
                      }
#pragma unroll
                      for (int r = 0; r < 4; ++r) { float s = ssr[r]; s += __shfl_xor(s, 1); s += __shfl_xor(s, 2); s += __shfl_xor(s, 4); s += __shfl_xor(s, 8); ssr[r] = __builtin_amdgcn_rsqf(s * (1.f / 256.f) + EPS); }
#pragma unroll
                      for (int gI = 0; gI < 4; ++gI)
#pragma unroll
                          for (int r = 0; r < 4; ++r) { const int p = p0 + 4 * fq + r; bf16* yp = Abuf + (size_t)(ci * 128 + p) * DM + 512 + gI * 64;
#pragma unroll
                              for (int nt = 0; nt < 4; ++nt) { const int c = 16 * nt + fr; yp[c] = (bf16)(pk2(acc[gI][nt][r] * ssr[r] * g_out[512 + gI * 64 + c], 0.f) & 0xffffu); } }
                    }
                    __syncthreads();
                }
                const int nq = last ? MLAT : MTOT, nsc = last ? MLAT : MTOT;
                const int hh = lane >> 3, j = lane & 7;
                const float* gqh = args.in[15] + l * DQK; const float* gkh = args.in[16] + l * DQK;
                float gq[12], gk[12];
#pragma unroll
                for (int i = 0; i < 8; ++i) { gq[i] = gqh[8 * j + i]; gk[i] = gkh[8 * j + i]; }
#pragma unroll
                for (int i = 0; i < 4; ++i) { gq[8 + i] = gqh[64 + 8 * i + j]; gk[8 + i] = gkh[64 + 8 * i + j]; }
#pragma unroll 4
                for (int row = gw; row < MTOT; row += NGW) {
                    const bool lat = row < MLAT; const int t = row & (SEQ - 1);
                    const bf16* mrow = MIX + (size_t)row * MIXP;
                    float cr = 1.f, sr = 0.f, cc = 1.f, sc = 0.f;
                    if (lat) { const f32x2 a = *(const f32x2*)(rope + 2 * ((t >> 6) * 8 + j)), b2 = *(const f32x2*)(rope + 2 * ((t & 63) * 8 + j)); cr = a.x; sr = a.y; cc = b2.x; sc = b2.y; }
                    float sq = 0.f, skv = 0.f;
                    if (lane < 48) { const u32x4 w = *(const u32x4*)(mrow + 8 * lane);
#pragma unroll
                        for (int e = 0; e < 4; ++e) { const float a = bflo(w[e]), b2 = bfhi(w[e]); sq += a * a + b2 * b2; } }
                    if (lane < 32) { const u32x4 w = *(const u32x4*)(mrow + OFF_KV + 8 * lane);
#pragma unroll
                        for (int e = 0; e < 4; ++e) { const float a = bflo(w[e]), b2 = bfhi(w[e]); skv += a * a + b2 * b2; } }
                    const float rq = __builtin_amdgcn_rsqf(wave_sum(sq) * (1.f / QLORA) + EPS), rkv = __builtin_amdgcn_rsqf(wave_sum(skv) * (1.f / KVLORA) + EPS);
                    if (row < nq) {
                        bf16* qp = QRAW + (size_t)row * 768 + hh * DQK;
                        const u32x4 w = *(const u32x4*)(qp + 8 * j); float z[12];
#pragma unroll
                        for (int e = 0; e < 4; ++e) { z[2 * e] = bflo(w[e]) * rq; z[2 * e + 1] = bfhi(w[e]) * rq; }
#pragma unroll
                        for (int i = 0; i < 4; ++i) z[8 + i] = bf1(qp[64 + 8 * i + j]) * rq;
                        float ss = 0.f;
#pragma unroll
                        for (int i = 0; i < 12; ++i) ss += z[i] * z[i];
                        ss += __shfl_xor(ss, 1); ss += __shfl_xor(ss, 2); ss += __shfl_xor(ss, 4);
                        const float hr = __builtin_amdgcn_rsqf(ss * (1.f / DQK) + EPS);
#pragma unroll
                        for (int i = 0; i < 12; ++i) z[i] *= hr * gq[i] * (att::SCALE * 1.4426950408889634f);
                        const float n0 = z[8] * cr - z[9] * sr, n1 = z[9] * cr + z[8] * sr, n2 = z[10] * cc - z[11] * sc, n3 = z[11] * cc + z[10] * sc;
                        u32x4 o; o.x = pk2(z[0], z[1]); o.y = pk2(z[2], z[3]); o.z = pk2(z[4], z[5]); o.w = pk2(z[6], z[7]);
                        *(u32x4*)(qp + 8 * j) = o;
                        qp[64 + j] = (bf16)(pk2(n0, 0.f) & 0xffffu); qp[72 + j] = (bf16)(pk2(n1, 0.f) & 0xffffu); qp[80 + j] = (bf16)(pk2(n2, 0.f) & 0xffffu); qp[88 + j] = (bf16)(pk2(n3, 0.f) & 0xffffu);
                    }
                    {
                        bf16* kvp = KVRAW + (size_t)row * 1024 + hh * 128;
                        const u32x4 w = *(const u32x4*)(kvp + 8 * j); float z[12];
#pragma unroll
                        for (int e = 0; e < 4; ++e) { z[2 * e] = bflo(w[e]) * rkv; z[2 * e + 1] = bfhi(w[e]) * rkv; }
#pragma unroll
                        for (int i = 0; i < 4; ++i) z[8 + i] = bf1(mrow[OFF_KPE + 8 * i + j]);
                        float ss = 0.f;
#pragma unroll
                        for (int i = 0; i < 12; ++i) ss += z[i] * z[i];
                        ss += __shfl_xor(ss, 1); ss += __shfl_xor(ss, 2); ss += __shfl_xor(ss, 4);
                        const float hr = __builtin_amdgcn_rsqf(ss * (1.f / DQK) + EPS);
#pragma unroll
                        for (int i = 0; i < 12; ++i) z[i] *= hr * gk[i];
                        const float n0 = z[8] * cr - z[9] * sr, n1 = z[9] * cr + z[8] * sr, n2 = z[10] * cc - z[11] * sc, n3 = z[11] * cc + z[10] * sc;
                        const int kb_ = lat ? (row >> 13) : ((row - MLAT) >> 8), ki_ = lat ? t : SEQ + ((row - MLAT) & (NCTX - 1));
                        bf16* kp = Kbuf + ((size_t)(kb_ * NH + hh) * (SEQ + NCTX) + ki_) * DQK;
                        u32x4 o; o.x = pk2(z[0], z[1]); o.y = pk2(z[2], z[3]); o.z = pk2(z[4], z[5]); o.w = pk2(z[6], z[7]);
                        *(u32x4*)(kp + 8 * j) = o;
                        kp[64 + j] = (bf16)(pk2(n0, 0.f) & 0xffffu); kp[72 + j] = (bf16)(pk2(n1, 0.f) & 0xffffu); kp[80 + j] = (bf16)(pk2(n2, 0.f) & 0xffffu); kp[88 + j] = (bf16)(pk2(n3, 0.f) & 0xffffu);
                        const u32x4 wv = *(const u32x4*)(kvp + 64 + 8 * j); u32x4 ov;
#pragma unroll
                        for (int e = 0; e < 4; ++e) ov[e] = pk2(bflo(wv[e]) * rkv, bfhi(wv[e]) * rkv);
                        *(u32x4*)(Vbuf + ((size_t)(kb_ * NH + hh) * (SEQ + NCTX) + ki_) * DV + 8 * j) = ov;
                    }
                    if (row < nsc) {
                        const int tt = lat ? t : (row & (NCTX - 1)); const int tmax = lat ? SEQ - 1 : NCTX - 1;
                        const float* wc = args.in[20] + l * 3 * 256 + 4 * lane;
                        f32x4 y = {0.f, 0.f, 0.f, 0.f};
#pragma unroll
                        for (int d = 0; d < 3; ++d) { const int t2 = tt + d - 1;
                            if (t2 >= 0 && t2 <= tmax) { const bf16* r2 = MIX + (size_t)(row + d - 1) * MIXP + OFF_CONV;
                                const u32x2 cg2 = *(const u32x2*)(r2 + 256 + 4 * lane), xi = *(const u32x2*)(r2 + 512 + 4 * lane); const f32x4 w4 = *(const f32x4*)(wc + d * 256);
                                y.x += w4.x * bflo(cg2.x) * bflo(xi.x); y.y += w4.y * bfhi(cg2.x) * bfhi(xi.x); y.z += w4.z * bflo(cg2.y) * bflo(xi.y); y.w += w4.w * bfhi(cg2.y) * bfhi(xi.y); } }
                        const u32x2 bg = *(const u32x2*)(mrow + OFF_CONV + 4 * lane);
                        y.x *= bflo(bg.x); y.y *= bfhi(bg.x); y.z *= bflo(bg.y); y.w *= bfhi(bg.y);
                        const float rs = __builtin_amdgcn_rsqf(wave_sum((y.x * y.x + y.y * y.y) + (y.z * y.z + y.w * y.w)) * (1.f / 256.f) + EPS);
                        const f32x4 gg = *(const f32x4*)(g_out + 768 + 4 * lane);
                        u32x2 o; o.x = pk2(y.x * rs * gg.x, y.y * rs * gg.y); o.y = pk2(y.z * rs * gg.z, y.w * rs * gg.w);
                        *(u32x2*)(Abuf + (size_t)row * DM + 768 + 4 * lane) = o;
                    }
                }
            } else if (k == 7 && PHEN(7)) {
                const int nlat = NB * NH * 32, nun = last ? nlat : nlat + NB * NH;
                float bl2;
                { const float* gqh = args.in[15] + l * DQK; const float* gkh = args.in[16] + l * DQK;
                  float a = fabsf(gqh[lane]), c = fabsf(gkh[lane]); if (lane < 32) { a = fmaxf(a, fabsf(gqh[64 + lane])); c = fmaxf(c, fabsf(gkh[64 + lane])); }
#pragma unroll
                  for (int o = 1; o < 64; o <<= 1) { a = fmaxf(a, __shfl_xor(a, o)); c = fmaxf(c, __shfl_xor(c, o)); }
                  bl2 = 1.02f * 96.f * a * c * (att::SCALE * 1.4426950408889634f); }
                const bool fastpath = bl2 <= 48.f;
                for (int u = bx; u < nun; u += G) {
                    int b, h, qrow0, tb, nt;
                    if (u < nlat) { const int rr = u / 256, i = u % 256; const int bh = (i & 7) * 4 + rr, qb = i >> 3; b = bh >> 3; h = bh & 7; qrow0 = b * SEQ + qb * 256; tb = 0; nt = 132; }
                    else { const int bh = u - nlat; b = bh >> 3; h = bh & 7; qrow0 = MLAT + b * NCTX; tb = 128; nt = 4; }
                    if (fastpath) att::attn_unit_m16(QRAW + (size_t)qrow0 * 768 + h * DQK, Kbuf + (size_t)(b * NH + h) * (SEQ + NCTX) * DQK, Vbuf + (size_t)(b * NH + h) * (SEQ + NCTX) * DV, Obuf + (size_t)qrow0 * 512 + h * DV, tb, nt, (LAS char*)lds, tid);
                    else att::attn_unit(QRAW + (size_t)qrow0 * 768 + h * DQK, Kbuf + (size_t)(b * NH + h) * (SEQ + NCTX) * DQK, Vbuf + (size_t)(b * NH + h) * (SEQ + NCTX) * DV, Obuf + (size_t)qrow0 * 512 + h * DV, b, tb, nt, (char*)lds_raw, tid);
                }
            } else if (k == 8 && PHEN(8)) {
                const float* g_out = args.in[21] + l * DM; const int nrows = last ? MLAT : MTOT;
#pragma unroll 2
                for (int row = gw; row < nrows; row += NGW) {
                    const u32x4 w = *(const u32x4*)(Obuf + (size_t)row * 512 + 8 * lane); float z[8]; float ss = 0.f;
#pragma unroll
                    for (int e = 0; e < 4; ++e) { z[2 * e] = bflo(w[e]); z[2 * e + 1] = bfhi(w[e]); ss += z[2 * e] * z[2 * e] + z[2 * e + 1] * z[2 * e + 1]; }
                    const float rs = __builtin_amdgcn_rsqf(wave_sum(ss) * (1.f / 512.f) + EPS);
                    const f32x4 g0 = *(const f32x4*)(g_out + 8 * lane), g1 = *(const f32x4*)(g_out + 8 * lane + 4);
                    u32x4 o; o.x = pk2(z[0] * rs * g0.x, z[1] * rs * g0.y); o.y = pk2(z[2] * rs * g0.z, z[3] * rs * g0.w); o.z = pk2(z[4] * rs * g1.x, z[5] * rs * g1.y); o.w = pk2(z[6] * rs * g1.z, z[7] * rs * g1.w);
                    *(u32x4*)(Abuf + (size_t)row * DM + 8 * lane) = o;
                }
            }
        }
#undef args
        if (ph + 1 < ph_hi) { XcdBarrier xb; xb.bar = (unsigned*)(ws + WS_CTL); xb.x = xb_xcc_id(); xb.st = MISC; xcd_barrier(xb); }
    }
}

extern "C" void kernel_launch(void* const* d_in, const int* in_sizes, int n_in, void* d_out, int out_size, void* d_ws, size_t ws_size, hipStream_t stream) {
    static int grid = 0;
    if (grid == 0) {
        if (n_in != 26 || in_sizes[0] != MLAT * DM || out_size != MLAT * DM || ws_size < WS_END) {
            fprintf(stderr, "kernel_launch: unexpected shapes (n_in %d, in0 %d, out %d, ws %zu, need %zu)\n", n_in, n_in > 0 ? in_sizes[0] : -1, out_size, ws_size, (size_t)WS_END); grid = -1; return; }
        int dev = 0, cus = 0, per_cu = 0;
        hipGetDevice(&dev); hipDeviceGetAttribute(&cus, hipDeviceAttributeMultiprocessorCount, dev);
        if (hipFuncSetAttribute((const void*)mk_fwd, hipFuncAttributeMaxDynamicSharedMemorySize, LDS_BYTES) != hipSuccess) { fprintf(stderr, "kernel_launch: hipFuncSetAttribute failed\n"); grid = -1; return; }
        if (hipOccupancyMaxActiveBlocksPerMultiprocessor(&per_cu, (const void*)mk_fwd, 512, LDS_BYTES) != hipSuccess || per_cu < 1) { fprintf(stderr, "kernel_launch: occupancy query gave %d\n", per_cu); per_cu = 1; }
        (void)hipGetLastError();
        grid = cus * per_cu;
        fprintf(stderr, "kernel_launch: grid %d (cus %d x %d)\n", grid, cus, per_cu);
    }
    if (grid < 0) return;
    if (hipMemsetAsync((char*)d_ws + WS_CTL, 0, CTL_BYTES, stream) != hipSuccess) { fprintf(stderr, "kernel_launch: memset failed\n"); return; }
    Args a{};
    for (int i = 0; i < 26; ++i) a.in[i] = (const float*)d_in[i];
    a.out = (float*)d_out; a.ws = (unsigned char*)d_ws;
#if MK_MULTI
    for (int p = 0; p < NPHASES; ++p) { a.ph_lo = p; a.ph_hi = p + 1; hipLaunchKernelGGL(mk_fwd, dim3(grid), dim3(512), LDS_BYTES, stream, a); }
#else
    a.ph_lo = 0; a.ph_hi = NPHASES;
    void* kargs[] = {&a};
    hipError_t e = hipLaunchCooperativeKernel((const void*)mk_fwd, dim3(grid), dim3(512), kargs, LDS_BYTES, stream);
    if (e != hipSuccess) fprintf(stderr, "kernel_launch: cooperative launch failed: %s (grid %d)\n", hipGetErrorString(e), grid);
#endif
}
```
